# Optimizing an MI355X kernel written in HIP

```python
import math
import jax, jax.numpy as jnp
from jax import lax
import numpy as np

D_MODEL = 2048
BATCH = 4
SEQ = 2048
DEPTH = 2
DEC_BATCH = 128
DEC_SEQ = 1
PAST_LEN = 16384
PAGE_SIZE = 128

D_FF = 5632
EPS = 1e-6
CHUNK = 64
N_BRANCH = 3
M_WIDTH = D_MODEL // 2
M_HEADDIM = 64
M_HEADS = M_WIDTH // M_HEADDIM
M_GROUPS = 2
M_STATE = 128
M_CONV = 4
M_CONV_DIM = M_WIDTH + 2 * M_GROUPS * M_STATE
H_WIDTH = D_MODEL // 2
H_EXPAND = 128
H_HEADS = H_WIDTH // H_EXPAND
G_WIDTH = D_MODEL // 2
G_KWIDTH = G_WIDTH // 2
G_HEADS = 4
G_DK = G_KWIDTH // G_HEADS
G_DV = G_WIDTH // G_HEADS
G_RANK = 16
G_NORMALIZER = 16.0
IN_SPLIT_WIDTHS = (M_WIDTH, M_CONV_DIM, M_HEADS,
                   H_WIDTH, H_WIDTH, H_WIDTH, H_WIDTH,
                   G_KWIDTH, G_KWIDTH, G_WIDTH, G_WIDTH, G_RANK,
                   N_BRANCH * D_MODEL)
IN_COLS = (M_WIDTH + M_CONV_DIM + M_HEADS + 4 * H_WIDTH + 2 * G_KWIDTH + 2 * G_WIDTH + G_RANK
           + N_BRANCH * D_MODEL)

kernel_name = 'hybrid_ssd_hgrn2_gla_macaron_step'

F32 = jnp.float32
F32_TINY = float(np.finfo(np.float32).tiny)


def _rmsnorm(x, w):
    x32 = x.astype(F32)
    y = x32 * lax.rsqrt(jnp.mean(x32 * x32, axis=-1, keepdims=True) + EPS)
    return (y * w.astype(F32)).astype(x.dtype)


def _swiglu(h, w_gate_up, w_down):
    g, u = jnp.split(h @ w_gate_up, 2, axis=-1)
    return (jax.nn.silu(g) * u) @ w_down


def _to_chunks(a, c):
    b, L = a.shape[:2]
    n = -(-L // c)
    a = jnp.pad(a, [(0, 0), (0, n * c - L)] + [(0, 0)] * (a.ndim - 2))
    a = a.reshape((b, n, c) + a.shape[2:])
    return jnp.moveaxis(a, 1, 0)


def _from_chunks(a, L):
    a = jnp.moveaxis(a, 0, 1)
    a = a.reshape((a.shape[0], -1) + a.shape[3:])
    return a[:, :L]


def _masked_decay(diff, mask):
    return jnp.where(mask, jnp.exp(jnp.where(mask, diff, 0.0)), 0.0)


def _ssd_scan(x, dt, a_head, bm, cm, s0):
    L = x.shape[1]
    c = min(CHUNK, L)
    mask = jnp.tril(jnp.ones((c, c), dtype=bool))[None, :, :, None, None]

    def step(s, inp):
        xc, dtc, bc, cc = inp
        cum = jnp.cumsum(dtc * a_head, axis=1)
        diff = cum[:, :, None] - cum[:, None, :]
        decay = _masked_decay(diff, mask)
        cb = jnp.einsum('btgn,bsgn->btsg', cc, bc)
        y = jnp.einsum('btsg,btsgj,bsgj,bsgjp->btgjp', cb, decay, dtc, xc)
        y = y + jnp.einsum('btgn,bgjpn,btgj->btgjp', cc, s, jnp.exp(cum))
        w = dtc * jnp.exp(cum[:, -1:] - cum)
        s = jnp.exp(cum[:, -1])[..., None, None] * s + jnp.einsum('bsgn,bsgj,bsgjp->bgjpn', bc, w, xc)
        return s, y

    xs = (_to_chunks(x.astype(F32), c), _to_chunks(dt.astype(F32), c),
          _to_chunks(bm.astype(F32), c), _to_chunks(cm.astype(F32), c))
    s, y = lax.scan(step, s0.astype(F32), xs)
    return _from_chunks(y, L), s


def _gla_scan(q, k, v, log_a, s0):
    L = q.shape[1]
    c = min(CHUNK, L)
    mask = jnp.tril(jnp.ones((c, c), dtype=bool))[None, :, :, None, None]

    def step(s, inp):
        qc, kc, vc, gc = inp
        cum = jnp.cumsum(gc, axis=1)
        diff = cum[:, :, None] - cum[:, None, :]
        decay = _masked_decay(diff, mask)
        att = jnp.einsum('bthd,btshd,bshd->bhts', qc, decay, kc)
        o = jnp.einsum('bhts,bshv->bthv', att, vc) + jnp.einsum('bthd,bhdv->bthv', qc * jnp.exp(cum), s)
        s = jnp.exp(cum[:, -1])[..., None] * s + jnp.einsum('bshd,bshv->bhdv', kc * jnp.exp(cum[:, -1:] - cum), vc)
        return s, o

    xs = (_to_chunks(q.astype(F32), c), _to_chunks(k.astype(F32), c),
          _to_chunks(v.astype(F32), c), _to_chunks(log_a.astype(F32), c))
    s, o = lax.scan(step, s0.astype(F32), xs)
    return _from_chunks(o, L), s


def _mamba_branch(z, xbc, dt_raw, conv_buf, s0, conv_w, conv_b, dt_bias, a_log, d_skip, norm_w):
    b, L = xbc.shape[:2]
    j = M_HEADS // M_GROUPS
    full = jnp.concatenate([conv_buf.astype(xbc.dtype), xbc], axis=1)
    new_buf = full[:, -(M_CONV - 1):]
    conv = lax.conv_general_dilated(full, conv_w[:, None, :].astype(full.dtype), window_strides=(1,),
                                    padding='VALID', dimension_numbers=('NWC', 'WIO', 'NWC'),
                                    feature_group_count=M_CONV_DIM)
    xbc = jax.nn.silu(conv + conv_b)
    xs, bm, cm = jnp.split(xbc, [M_WIDTH, M_WIDTH + M_GROUPS * M_STATE], axis=-1)
    xs = xs.reshape(b, L, M_GROUPS, j, M_HEADDIM)
    bm = bm.reshape(b, L, M_GROUPS, M_STATE)
    cm = cm.reshape(b, L, M_GROUPS, M_STATE)
    dt = jax.nn.softplus((dt_raw + dt_bias).astype(F32)).reshape(b, L, M_GROUPS, j)
    a = -jnp.exp(a_log.astype(F32)).reshape(M_GROUPS, j)
    y, s = _ssd_scan(xs, dt, a, bm, cm, s0.reshape(b, M_GROUPS, j, M_HEADDIM, M_STATE))
    y = y + d_skip.astype(F32).reshape(M_GROUPS, j)[:, :, None] * xs.astype(F32)
    y = y.reshape(b, L, M_WIDTH) * jax.nn.silu(z.astype(F32))
    gs = M_WIDTH // M_GROUPS
    y = _rmsnorm(y.reshape(b, L, M_GROUPS, gs), norm_w.reshape(M_GROUPS, gs)).reshape(b, L, M_WIDTH)
    return y.astype(z.dtype), new_buf, s.reshape(b, M_HEADS, M_HEADDIM, M_STATE)


def _hgrn2_branch(hq, hf, hi, hg, s0, lb, norm_w):
    b, L = hq.shape[:2]
    shp = (b, L, H_HEADS, H_EXPAND)
    q = jax.nn.silu(hq.astype(F32)).reshape(shp) * H_EXPAND ** -0.5
    zf = hf.astype(F32)
    lb = lb.astype(F32)
    f = lb + (1.0 - lb) * jax.nn.sigmoid(zf)
    log_f = jnp.log(jnp.maximum(f, F32_TINY))
    k = (1.0 - lb) * jax.nn.sigmoid(-zf)
    o, s = _gla_scan(q, k.reshape(shp), hi.astype(F32).reshape(shp), log_f.reshape(shp), s0)
    o = _rmsnorm(o, norm_w) * jax.nn.silu(hg.astype(F32)).reshape(shp)
    return o.reshape(b, L, H_WIDTH).astype(hq.dtype), s


def _gla_branch(gq, gk, gv, gg, ga, s0, w_decay, b_decay, norm_w):
    b, L = gq.shape[:2]
    q = gq.astype(F32).reshape(b, L, G_HEADS, G_DK) * G_DK ** -0.5
    k = gk.astype(F32).reshape(b, L, G_HEADS, G_DK)
    v = gv.astype(F32).reshape(b, L, G_HEADS, G_DV)
    log_a = jax.nn.log_sigmoid((ga @ w_decay + b_decay).astype(F32)) / G_NORMALIZER
    o, s = _gla_scan(q, k, v, log_a.reshape(b, L, G_HEADS, G_DK), s0)
    o = _rmsnorm(o, norm_w) * jax.nn.silu(gg.astype(F32)).reshape(b, L, G_HEADS, G_DV)
    return o.reshape(b, L, G_WIDTH).astype(gq.dtype), s


def _layer(x, conv_buf, s_ssm, s_hgrn, s_gla, lb, p):
    b, L = x.shape[:2]
    x = x + 0.5 * _swiglu(_rmsnorm(x, p['ffn1_norm']), p['ffn1_w_gate_up'], p['ffn1_w_down'])
    h = _rmsnorm(x, p['mix_norm'])
    offs = np.cumsum(IN_SPLIT_WIDTHS)[:-1].tolist()
    (m_z, m_xbc, m_dt, h_q, h_f, h_i, h_g, g_q, g_k, g_v, g_g, g_a, gate) = jnp.split(h @ p['w_in'], offs, axis=-1)
    y_m, new_conv, new_ssm = _mamba_branch(m_z, m_xbc, m_dt, conv_buf, s_ssm, p['conv_w'], p['conv_b'],
                                           p['dt_bias'], p['a_log'], p['d_skip'], p['mamba_norm'])
    y_h, new_hgrn = _hgrn2_branch(h_q, h_f, h_i, h_g, s_hgrn, lb, p['hgrn_norm'])
    y_g, new_gla = _gla_branch(g_q, g_k, g_v, g_g, g_a, s_gla, p['gla_w_decay'], p['gla_b_decay'], p['gla_norm'])
    gates = jax.nn.sigmoid(gate.astype(F32)).reshape(b, L, N_BRANCH, D_MODEL).astype(x.dtype)
    merged = (gates[:, :, 0] * (y_m @ p['w_branch_mamba'])
              + gates[:, :, 1] * (y_h @ p['w_branch_hgrn'])
              + gates[:, :, 2] * (y_g @ p['w_branch_gla']))
    x = x + merged @ p['w_out']
    x = x + 0.5 * _swiglu(_rmsnorm(x, p['ffn2_norm']), p['ffn2_w_gate_up'], p['ffn2_w_down'])
    return x, new_conv, new_ssm, new_hgrn, new_gla


def setup_inputs(seed: int = 0) -> dict:
    key = jax.random.key(seed)
    ks = jax.random.split(key, 32)

    def nrm(i, shape, scale):
        return jax.random.normal(ks[i], shape, F32) * scale

    def gain(i, shape):
        return 1.0 + 0.02 * jax.random.normal(ks[i], shape, F32)

    dt0 = jnp.exp(jax.random.uniform(ks[12], (DEPTH, M_HEADS), F32)
                  * (math.log(0.1) - math.log(0.001)) + math.log(0.001))
    dt_bias = dt0 + jnp.log(-jnp.expm1(-dt0))
    a_log = jnp.log(jax.random.uniform(ks[13], (DEPTH, M_HEADS), F32, 1.0, 16.0))
    return {
        'x_prompt': nrm(0, (BATCH, SEQ, D_MODEL), 1.0),
        'x_sample': nrm(1, (DEC_BATCH, DEC_SEQ, D_MODEL), 1.0),
        'state_conv': nrm(2, (DEPTH, DEC_BATCH, M_CONV - 1, M_CONV_DIM), 1.0),
        'state_ssm': nrm(3, (DEPTH, DEC_BATCH, M_HEADS, M_HEADDIM, M_STATE), 0.5),
        'state_hgrn': nrm(4, (DEPTH, DEC_BATCH, H_HEADS, H_EXPAND, H_EXPAND), 1.0),
        'state_gla': nrm(5, (DEPTH, DEC_BATCH, G_HEADS, G_DK, G_DV), 1.0),
        'ffn1_norm': gain(6, (DEPTH, D_MODEL)),
        'ffn1_w_gate_up': nrm(7, (DEPTH, D_MODEL, 2 * D_FF), D_MODEL ** -0.5),
        'ffn1_w_down': nrm(8, (DEPTH, D_FF, D_MODEL), D_FF ** -0.5),
        'mix_norm': gain(9, (DEPTH, D_MODEL)),
        'w_in': nrm(10, (DEPTH, D_MODEL, IN_COLS), D_MODEL ** -0.5),
        'conv_w': nrm(11, (DEPTH, M_CONV, M_CONV_DIM), M_CONV ** -0.5),
        'conv_b': nrm(14, (DEPTH, M_CONV_DIM), 0.02),
        'dt_bias': dt_bias,
        'a_log': a_log,
        'd_skip': gain(15, (DEPTH, M_HEADS)),
        'mamba_norm': gain(16, (DEPTH, M_WIDTH)),
        'hgrn_lb_logits': nrm(17, (DEPTH, H_WIDTH), 1.0),
        'hgrn_norm': gain(18, (DEPTH, H_EXPAND)),
        'gla_w_decay': nrm(19, (DEPTH, G_RANK, G_KWIDTH), G_RANK ** -0.5),
        'gla_b_decay': nrm(20, (DEPTH, G_KWIDTH), 0.02),
        'gla_norm': gain(21, (DEPTH, G_DV)),
        'w_branch_mamba': nrm(22, (DEPTH, M_WIDTH, D_MODEL), M_WIDTH ** -0.5),
        'w_branch_hgrn': nrm(23, (DEPTH, H_WIDTH, D_MODEL), H_WIDTH ** -0.5),
        'w_branch_gla': nrm(24, (DEPTH, G_WIDTH, D_MODEL), G_WIDTH ** -0.5),
        'w_out': nrm(25, (DEPTH, D_MODEL, D_MODEL), D_MODEL ** -0.5),
        'ffn2_norm': gain(26, (DEPTH, D_MODEL)),
        'ffn2_w_gate_up': nrm(27, (DEPTH, D_MODEL, 2 * D_FF), D_MODEL ** -0.5),
        'ffn2_w_down': nrm(28, (DEPTH, D_FF, D_MODEL), D_FF ** -0.5),
        'final_norm': gain(29, (D_MODEL,)),
    }


def reference(x_prompt, x_sample, state_conv, state_ssm, state_hgrn, state_gla,
              ffn1_norm, ffn1_w_gate_up, ffn1_w_down, mix_norm, w_in, conv_w, conv_b,
              dt_bias, a_log, d_skip, mamba_norm, hgrn_lb_logits, hgrn_norm,
              gla_w_decay, gla_b_decay, gla_norm, w_branch_mamba, w_branch_hgrn, w_branch_gla,
              w_out, ffn2_norm, ffn2_w_gate_up, ffn2_w_down, final_norm):
    sm = jax.nn.softmax(hgrn_lb_logits.astype(F32), axis=0)
    lower_bounds = jnp.cumsum(sm, axis=0) - sm[0]

    bp = x_prompt.shape[0]
    sdt = state_ssm.dtype
    xp, xs = x_prompt, x_sample
    pc, ps, ph, pg = [], [], [], []
    sc, ss, sh, sg = [], [], [], []
    for l in range(DEPTH):
        p = {'ffn1_norm': ffn1_norm[l], 'ffn1_w_gate_up': ffn1_w_gate_up[l], 'ffn1_w_down': ffn1_w_down[l],
             'mix_norm': mix_norm[l], 'w_in': w_in[l], 'conv_w': conv_w[l], 'conv_b': conv_b[l],
             'dt_bias': dt_bias[l], 'a_log': a_log[l], 'd_skip': d_skip[l], 'mamba_norm': mamba_norm[l],
             'hgrn_norm': hgrn_norm[l], 'gla_w_decay': gla_w_decay[l], 'gla_b_decay': gla_b_decay[l],
             'gla_norm': gla_norm[l], 'w_branch_mamba': w_branch_mamba[l], 'w_branch_hgrn': w_branch_hgrn[l],
             'w_branch_gla': w_branch_gla[l], 'w_out': w_out[l], 'ffn2_norm': ffn2_norm[l],
             'ffn2_w_gate_up': ffn2_w_gate_up[l], 'ffn2_w_down': ffn2_w_down[l]}
        lb = lower_bounds[l]
        xp, c1, s1, h1, g1 = _layer(
            xp,
            jnp.zeros((bp, M_CONV - 1, M_CONV_DIM), x_prompt.dtype),
            jnp.zeros((bp, M_HEADS, M_HEADDIM, M_STATE), F32),
            jnp.zeros((bp, H_HEADS, H_EXPAND, H_EXPAND), F32),
            jnp.zeros((bp, G_HEADS, G_DK, G_DV), F32),
            lb, p)
        xs, c2, s2, h2, g2 = _layer(xs, state_conv[l], state_ssm[l], state_hgrn[l], state_gla[l], lb, p)
        pc.append(c1.astype(state_conv.dtype)); ps.append(s1.astype(sdt))
        ph.append(h1.astype(state_hgrn.dtype)); pg.append(g1.astype(state_gla.dtype))
        sc.append(c2.astype(state_conv.dtype)); ss.append(s2.astype(sdt))
        sh.append(h2.astype(state_hgrn.dtype)); sg.append(g2.astype(state_gla.dtype))
    y_prompt = _rmsnorm(xp, final_norm)
    y_sample = _rmsnorm(xs, final_norm)
    return (y_prompt, y_sample,
            jnp.stack(pc), jnp.stack(ps), jnp.stack(ph), jnp.stack(pg),
            jnp.stack(sc), jnp.stack(ss), jnp.stack(sh), jnp.stack(sg))
```

```cpp
#include <hip/hip_runtime.h>
#include <cstdio>
#include <cstdint>

#ifndef PHMASK
#define PHMASK 0xFFFF
#endif
#define PHON(k) ((PHMASK >> (k)) & 1)
#ifndef MK_PER_PHASE
#define MK_PER_PHASE 1
#endif

#define LAS __attribute__((address_space(3)))
#define GAS __attribute__((address_space(1)))
typedef unsigned short bf16_t;
typedef short bf16x8 __attribute__((ext_vector_type(8)));
typedef float f32x4 __attribute__((ext_vector_type(4)));
typedef float f32x2 __attribute__((ext_vector_type(2)));
typedef unsigned u32x4 __attribute__((ext_vector_type(4)));
typedef unsigned u32x2 __attribute__((ext_vector_type(2)));

constexpr int DM = 2048, DFF = 5632, SEQ = 2048, NB = 4, NPROMPT = NB * SEQ, NSAMP = 128, NTOK = NPROMPT + NSAMP, MP = 8448  , DEPTH = 2;
constexpr int INC = 15904, INP = 16128;
constexpr float EPS = 1e-6f;
constexpr int PC_Z = 0, PC_XBC = 1024, PC_HQ = 2560, PC_HF = 3584, PC_HI = 4608, PC_HG = 5632, PC_GQ = 6656, PC_GK = 7168, PC_GV = 7680, PC_GG = 8704, PC_GATE = 9728, PC_DT = 15872, PC_GA = 15888;
constexpr size_t O_YP = 0, O_YS = 16777216, O_CP = 17039360, O_SP = 17076224, O_HP = 18124800, O_GP = 19173376, O_CS = 20221952, O_SS = 21401600, O_HS = 54956032, O_GS = 88510464, O_END = 122064896;

constexpr size_t MiB = 1u << 20;
constexpr size_t WS_CTL = 0, CTL_ZERO_BYTES = 1 * MiB;
constexpr size_t WS_LB = 1 * MiB, WS_DT = 2 * MiB, WS_LGA = 3 * MiB, WS_XC = 20 * MiB, WS_X = 45 * MiB, WS_XB = 111 * MiB, WS_ACT = 144 * MiB, WS_PROJ = 235 * MiB,
                 WS_O = 495 * MiB, WS_Y = 594 * MiB, WS_PART = 644 * MiB, WS_MRG = 710 * MiB, WS_W = 743 * MiB;
constexpr size_t WL_GU1 = 0, WL_D1 = 44 * MiB, WL_IN = 66 * MiB, WL_BR = 129 * MiB, WL_OUT = 141 * MiB, WL_GU2 = 149 * MiB, WL_D2 = 193 * MiB, WL_STRIDE = 215 * MiB;
constexpr size_t WS_END = WS_W + 2 * WL_STRIDE;
constexpr int CW_BAR = 4096;
constexpr size_t CTL_SSQ = 512 * 1024;
constexpr int LDS_BYTES = 147456;
constexpr int MISC_OFF = 131072 + 320;

__device__ __forceinline__ float bf2f(unsigned b) { return __uint_as_float(b << 16); }
__device__ __forceinline__ unsigned f2bf(float f) { unsigned u = __float_as_uint(f); return (u + 0x7fffu + ((u >> 16) & 1u)) >> 16; }
__device__ __forceinline__ unsigned pk2(float lo, float hi) { return f2bf(lo) | (f2bf(hi) << 16); }
__device__ __forceinline__ unsigned cvt_pk_bf16(float lo, float hi) { unsigned r; asm volatile("v_cvt_pk_bf16_f32 %0, %1, %2" : "=v"(r) : "v"(lo), "v"(hi)); return r; }
__device__ __forceinline__ float fast_rcp(float x) { return __builtin_amdgcn_rcpf(x); }
__device__ __forceinline__ float sigmoidf_(float x) { return fast_rcp(1.0f + __expf(-x)); }
__device__ __forceinline__ float siluf_(float x) { return x * sigmoidf_(x); }
__device__ __forceinline__ float softplusf_(float x) { return x > 20.f ? x : log1pf(__expf(x)); }
__device__ __forceinline__ float wave_sum(float v) {
#pragma unroll
    for (int o = 1; o < 64; o <<= 1) v += __shfl_xor(v, o);
    return v;
}
#define LDS_WAIT() asm volatile("s_waitcnt lgkmcnt(0)" ::: "memory")
#define VM_WAIT() asm volatile("s_waitcnt vmcnt(0)" ::: "memory")

#define XB_TMO      128
#define XB_XCNT(j)  (256  + 64 * (j))
#define XB_XSUB(j)  (1280 + 64 * (j))
#define XB_XGEN(j)  (2304 + 64 * (j))
#define XB_TOP      3328
#define XB_TOPGEN   3392
#define XCD_BAR_WORDS 3456
#define XB_SPIN_CAP (1u << 18)
__device__ __forceinline__ unsigned xb_ld(unsigned* p)              { return __hip_atomic_load(p, __ATOMIC_RELAXED, __HIP_MEMORY_SCOPE_AGENT); }
__device__ __forceinline__ unsigned xb_add(unsigned* p, unsigned v) { return __hip_atomic_fetch_add(p, v, __ATOMIC_RELAXED, __HIP_MEMORY_SCOPE_AGENT); }
__device__ __forceinline__ unsigned xb_xcc_id() { return (unsigned)__builtin_amdgcn_s_getreg((3 << 11) | 20) & 0xFu; }
#define XB_SPIN(cond, bar) do { unsigned _sp = 0; while (cond) { __builtin_amdgcn_s_sleep(1); \
    if ((++_sp & 255u) == 0u) { if (xb_ld(&(bar)[XB_TMO])) break; if (_sp > XB_SPIN_CAP) { atomicAdd(&(bar)[XB_TMO], 1u); break; } } } } while (0)
struct XcdBarrier { unsigned* bar; unsigned x; volatile LAS unsigned* st; };
__device__ __forceinline__ XcdBarrier xcd_barrier_post(unsigned* bar, volatile LAS unsigned* st) {
    XcdBarrier b; b.bar = bar; b.x = xb_xcc_id(); b.st = st;
    if (threadIdx.x == 0) (void)xb_add(&bar[XB_XCNT(b.x)], 1u);
    return b;
}
__device__ __forceinline__ void xcd_barrier_complete(unsigned* bar, unsigned x, unsigned& nloc, unsigned& nx) {
    const unsigned G = gridDim.x * gridDim.y * gridDim.z;
    unsigned sum, cnt, mine, sp = 0u;
    for (;;) {
        sum = 0u; cnt = 0u; mine = 0u;
#pragma unroll
        for (unsigned j = 0; j < 16; ++j) { const unsigned c = xb_ld(&bar[XB_XCNT(j)]); sum += c; cnt += (c > 0u) ? 1u : 0u; mine = (j == x) ? c : mine; }
        if (sum == G) break;
        __builtin_amdgcn_s_sleep(1);
        if ((++sp & 255u) == 0u) { if (xb_ld(&bar[XB_TMO])) break; if (sp > XB_SPIN_CAP) { atomicAdd(&bar[XB_TMO], 1u); break; } }
    }
    nloc = mine > 0u ? mine : 1u; nx = cnt > 0u ? cnt : 1u;
}
__device__ __forceinline__ void xcd_barrier(const XcdBarrier& b) {
    asm volatile("s_waitcnt vmcnt(0)" ::: "memory");
    __syncthreads();
    if (threadIdx.x == 0) {
        unsigned* bar = b.bar;
        __builtin_amdgcn_s_waitcnt(0);
        unsigned nloc = b.st[0], nx = b.st[1];
        if (nloc == 0u) { xcd_barrier_complete(bar, b.x, nloc, nx); b.st[0] = nloc; b.st[1] = nx; }
        const unsigned old = xb_add(&bar[XB_XSUB(b.x)], 1u);
        const unsigned gen = old / nloc;
        if (old + 1u == (gen + 1u) * nloc) {
            __builtin_amdgcn_fence(__ATOMIC_RELEASE, "agent");
            asm volatile("s_waitcnt vmcnt(0)" ::: "memory");
            const unsigned og = xb_add(&bar[XB_TOP], 1u);
            const unsigned tg = og / nx;
            if (og + 1u == (tg + 1u) * nx) xb_add(&bar[XB_TOPGEN], 1u);
            else XB_SPIN(xb_ld(&bar[XB_TOPGEN]) == tg, bar);
            __builtin_amdgcn_fence(__ATOMIC_ACQUIRE, "agent");
            xb_add(&bar[XB_XGEN(b.x)], 1u);
            asm volatile("s_waitcnt vmcnt(0)" ::: "memory");
        } else {
            XB_SPIN(xb_ld(&bar[XB_XGEN(b.x)]) == gen, bar);
            __builtin_amdgcn_fence(__ATOMIC_ACQUIRE, "agent");
            asm volatile("s_waitcnt vmcnt(0)" ::: "memory");
        }
    }
    __syncthreads();
}

namespace pg8 {
constexpr int BM = 256, BK = 64, HALF = 128, HTB = HALF * BK * 2, STAGE_BYTES = 8 * HTB, NXCD = 8, WGM = 8;
__host__ __device__ __forceinline__ int lds_byte(int r, int c) { const int st = (r >> 4) * 2 + (c >> 5), rr = r & 15, cc = c & 31, ob = rr * 64 + cc * 2; return st * 1024 + (ob ^ (((ob >> 9) & 1) << 5)); }
__host__ __device__ __forceinline__ void stage_rc(int b, int& R, int& C) { const int st = b / 1024, sb = b % 1024, swz = sb ^ (((sb >> 9) & 1) << 5); R = (st >> 1) * 16 + swz / 64; C = (st & 1) * 32 + (swz % 64) / 2; }
__host__ __device__ __forceinline__ int perm32(int rho) { const int n = rho >> 4, i = rho & 15; return 8 * (i >> 2) + 4 * n + (i & 3); }

struct Unit { int pm, pn, kb; };
struct Gemm { const bf16_t* A; const bf16_t* Bt; int lda, ldb, K; };

template <int NK> struct Order {
    int nM, nN, nwg, G, c;
    __device__ void init(int nM_, int nN_, int G_, int c_) { nM = nM_; nN = nN_; nwg = nM * nN; G = G_; c = c_; }
    __device__ bool next(int i, Unit& u) const {
        const int it = i / NK; u.kb = i - it * NK;
        const long L = (long)it * G + c; if (L >= nwg) return false;
        int wgid = (int)L; { const int q = nwg / NXCD, r = nwg % NXCD, xcd = wgid % NXCD, off = wgid / NXCD; wgid = (xcd < r ? xcd * (q + 1) : r * (q + 1) + (xcd - r) * q) + off; }
        const int nig = WGM * nN, gid = wgid / nig, fm = gid * WGM, gsz = (nM - fm) < WGM ? (nM - fm) : WGM;
        u.pm = fm + ((wgid % nig) % gsz); u.pn = (wgid % nig) / gsz; return true;
    }
};


struct EpiSwiGLU {
    static constexpr bool PERM = true;
    bf16_t* O; const float* ssq;
    __device__ __forceinline__ void operator()(const f32x4 (&acc)[2][2][4][2], const Unit& u, int wr, int wc, int fr, int fq) const {
        const int row0 = u.pm * BM + wr * 64 + fr, col0 = u.pn * HALF + wc * 32 + 8 * fq;
#pragma unroll
        for (int ai = 0; ai < 2; ++ai)
#pragma unroll
            for (int m = 0; m < 4; ++m) {
                const int row = row0 + ai * HALF + m * 16;
                const float rs = rsqrtf(ssq[row] * (1.0f / DM) + EPS);
                float h[8];
#pragma unroll
                for (int n = 0; n < 2; ++n)
#pragma unroll
                    for (int j = 0; j < 4; ++j) { const float g = acc[ai][0][m][n][j] * rs, up = acc[ai][1][m][n][j] * rs; h[n * 4 + j] = siluf_(g) * up; }
                u32x4 w; w.x = cvt_pk_bf16(h[0], h[1]); w.y = cvt_pk_bf16(h[2], h[3]); w.z = cvt_pk_bf16(h[4], h[5]); w.w = cvt_pk_bf16(h[6], h[7]);
                *(u32x4*)(O + (size_t)row * DFF + col0) = w;
            }
    }
};
struct EpiResid {
    static constexpr bool PERM = false;
    float* X; bf16_t* XB; float* ssq_out; float scale;
    __device__ __forceinline__ void operator()(const f32x4 (&acc)[2][2][4][2], const Unit& u, int wr, int wc, int fr, int fq) const {
        const int row0 = u.pm * BM + wr * 64 + fr, col0 = u.pn * BM + wc * 32 + 4 * fq;
#pragma unroll
        for (int ai = 0; ai < 2; ++ai)
#pragma unroll
            for (int m = 0; m < 4; ++m) {
                const int row = row0 + ai * HALF + m * 16; float ss = 0.f;
                float* xp = X + (size_t)row * DM + col0; bf16_t* bp = XB + (size_t)row * DM + col0;
#pragma unroll
                for (int bj = 0; bj < 2; ++bj)
#pragma unroll
                    for (int n = 0; n < 2; ++n) {
                        const f32x4 b = *(const f32x4*)(xp + bj * HALF + n * 16);
                        const f32x4 o = b + acc[ai][bj][m][n] * scale;
                        *(f32x4*)(xp + bj * HALF + n * 16) = o;
                        ss += (o[0] * o[0] + o[1] * o[1]) + (o[2] * o[2] + o[3] * o[3]);
                        u32x2 w; w.x = cvt_pk_bf16(o[0], o[1]); w.y = cvt_pk_bf16(o[2], o[3]);
                        *(u32x2*)(bp + bj * HALF + n * 16) = w;
                    }
                ss += __shfl_xor(ss, 16); ss += __shfl_xor(ss, 32);
                if (fq == 0) atomicAdd(ssq_out + row, ss);
            }
    }
};
struct EpiProj {
    static constexpr bool PERM = true;
    bf16_t* O; const float* ssq;
    __device__ __forceinline__ void operator()(const f32x4 (&acc)[2][2][4][2], const Unit& u, int wr, int wc, int fr, int fq) const {
        const int row0 = u.pm * BM + wr * 64 + fr, col0 = u.pn * BM + wc * 32 + 8 * fq;
#pragma unroll
        for (int ai = 0; ai < 2; ++ai)
#pragma unroll
            for (int m = 0; m < 4; ++m) {
                const int row = row0 + ai * HALF + m * 16;
                const float rs = rsqrtf(ssq[row] * (1.0f / DM) + EPS);
#pragma unroll
                for (int bj = 0; bj < 2; ++bj) { const f32x4 v0 = acc[ai][bj][m][0] * rs, v1 = acc[ai][bj][m][1] * rs;
                    u32x4 w; w.x = cvt_pk_bf16(v0[0], v0[1]); w.y = cvt_pk_bf16(v0[2], v0[3]); w.z = cvt_pk_bf16(v1[0], v1[1]); w.w = cvt_pk_bf16(v1[2], v1[3]);
                    *(u32x4*)(O + (size_t)row * INP + col0 + bj * HALF) = w; }
            }
    }
};
struct EpiBranch {
    static constexpr bool PERM = true;
    const bf16_t* PROJ; float* PART; bf16_t* MRG;
    __device__ __forceinline__ void operator()(const f32x4 (&acc)[2][2][4][2], const Unit& u, int wr, int wc, int fr, int fq) const {
        const int row0 = u.pm * BM + wr * 64 + fr, col0 = u.pn * BM + wc * 32 + 8 * fq;
#pragma unroll
        for (int ai = 0; ai < 2; ++ai)
#pragma unroll
            for (int m = 0; m < 4; ++m) {
                const int row = row0 + ai * HALF + m * 16;
#pragma unroll
                for (int bj = 0; bj < 2; ++bj) {
                    const int col = col0 + bj * HALF;
                    const u32x4 gw = *(const u32x4*)(PROJ + (size_t)row * INP + PC_GATE + u.kb * DM + col);
                    float v[8];
#pragma unroll
                    for (int j = 0; j < 4; ++j) { const unsigned w = gw[j]; const float g0 = sigmoidf_(bf2f(w & 0xffffu)), g1 = sigmoidf_(bf2f(w >> 16));
                        const int e = 2 * j; v[e] = g0 * acc[ai][bj][m][e >> 2][e & 3]; v[e + 1] = g1 * acc[ai][bj][m][(e + 1) >> 2][(e + 1) & 3]; }
                    float* pp = PART + (size_t)row * DM + col;
                    if (u.kb != 0) { const f32x4 p0 = *(const f32x4*)pp, p1 = *(const f32x4*)(pp + 4);
#pragma unroll
                        for (int j = 0; j < 4; ++j) { v[j] += p0[j]; v[4 + j] += p1[j]; } }
                    if (u.kb != 2) { *(f32x4*)pp = (f32x4){v[0], v[1], v[2], v[3]}; *(f32x4*)(pp + 4) = (f32x4){v[4], v[5], v[6], v[7]}; }
                    else { u32x4 w; w.x = cvt_pk_bf16(v[0], v[1]); w.y = cvt_pk_bf16(v[2], v[3]); w.z = cvt_pk_bf16(v[4], v[5]); w.w = cvt_pk_bf16(v[6], v[7]);
                        *(u32x4*)(MRG + (size_t)row * DM + col) = w; }
                }
            }
    }
};

template <class Epi, class Sched>
__device__ __forceinline__ void gemm_phase(LAS unsigned char* lds, const Gemm g, const Sched& S, const Epi& E) {
    int tid = threadIdx.x; asm volatile("" : "+v"(tid));
    const int wid = __builtin_amdgcn_readfirstlane(tid >> 6), lane = tid & 63, wr = wid >> 2, wc = wid & 3, fr = lane & 15, fq = lane >> 4;
    const int K = g.K, nt = K / BK;
    unsigned voffA[2], voffB[2];
#pragma unroll
    for (int i = 0; i < 2; ++i) { int R, C; stage_rc(tid * 16 + i * 8192, R, C); const int Rb = Epi::PERM ? ((R & ~31) + perm32(R & 31)) : R;
        voffA[i] = (unsigned)(R * g.lda + C) * 2u; voffB[i] = (unsigned)(Rb * g.ldb + C) * 2u; }
    const size_t kstep = (size_t)(BK * 2);
    const size_t hstepA = (size_t)HALF * g.lda * 2, hstepB = (size_t)HALF * g.ldb * 2;
    const size_t tstepA = 2 * hstepA, tstepB = 2 * hstepB, kbstep = (size_t)K * 2;
    const unsigned ldsw = (unsigned)wid * 1024u;
    const int aoff = lds_byte(wr * 64 + fr, fq * 8), boff = lds_byte(wc * 32 + fr, fq * 8);
#define PG8_SA(b, h) (((b) * 2 + (h)) * HTB)
#define PG8_SB(b, h) ((4 + (b) * 2 + (h)) * HTB)
#define PG8_STAGE(bufoff, gbase, voff) do { _Pragma("unroll") for (int _i = 0; _i < 2; ++_i) \
        __builtin_amdgcn_global_load_lds((const unsigned*)((const char*)(gbase) + (voff)[_i]), (LAS unsigned*)(lds + (bufoff) + ldsw + _i * 8192), 16, 0, 0); } while (0)
#define PG8_LDA(dst, b, h) do { _Pragma("unroll") for (int m = 0; m < 4; ++m) _Pragma("unroll") for (int k = 0; k < 2; ++k) dst[m][k] = *(const LAS bf16x8*)(lds + PG8_SA(b, h) + aoff + m * 2048 + k * 1024); } while (0)
#define PG8_LDB(dst, b, h) do { _Pragma("unroll") for (int n = 0; n < 2; ++n) _Pragma("unroll") for (int k = 0; k < 2; ++k) dst[n][k] = *(const LAS bf16x8*)(lds + PG8_SB(b, h) + boff + n * 2048 + k * 1024); } while (0)
#define PG8_MMA(ai, bj, At, Bt) do { __builtin_amdgcn_s_setprio(1); _Pragma("unroll") for (int m = 0; m < 4; ++m) _Pragma("unroll") for (int n = 0; n < 2; ++n) _Pragma("unroll") for (int k = 0; k < 2; ++k) \
        acc[ai][bj][m][n] = __builtin_amdgcn_mfma_f32_16x16x32_bf16(Bt[n][k], At[m][k], acc[ai][bj][m][n], 0, 0, 0); __builtin_amdgcn_s_setprio(0); } while (0)
#define PG8_WAIT_V(n) asm volatile("s_waitcnt vmcnt(" #n ")" ::: "memory")
#define PG8_WAIT_L(n) asm volatile("s_waitcnt lgkmcnt(" #n ")" ::: "memory")
#define PG8_BAR __builtin_amdgcn_s_barrier()
#define PG8_SCHED __builtin_amdgcn_sched_barrier(0)
    Unit cur, nxt; int ui = 0;
    if (!S.next(0, cur)) return;
    f32x4 acc[2][2][4][2];
#pragma unroll
    for (int a = 0; a < 2; ++a)
#pragma unroll
        for (int b = 0; b < 2; ++b)
#pragma unroll
            for (int m = 0; m < 4; ++m)
#pragma unroll
                for (int n = 0; n < 2; ++n) acc[a][b][m][n] = (f32x4){0.f, 0.f, 0.f, 0.f};
    bf16x8 At[4][2], B0[2][2], B1[2][2];
    const char* cA = (const char*)g.A + (size_t)cur.pm * tstepA + (size_t)cur.kb * kbstep; const char* cB = (const char*)g.Bt + (size_t)cur.pn * tstepB + (size_t)cur.kb * kbstep;
    PG8_STAGE(PG8_SB(0, 0), cB, voffB); PG8_STAGE(PG8_SB(0, 1), cB + hstepB, voffB); PG8_STAGE(PG8_SA(0, 0), cA, voffA); PG8_STAGE(PG8_SA(0, 1), cA + hstepA, voffA);
    if (wr == 1) PG8_BAR;
    PG8_WAIT_V(2); PG8_BAR;
    PG8_STAGE(PG8_SB(1, 0), cB + kstep, voffB); PG8_STAGE(PG8_SA(1, 0), cA + kstep, voffA); PG8_STAGE(PG8_SB(1, 1), cB + hstepB + kstep, voffB);
    PG8_WAIT_V(6); PG8_BAR;
    for (;;) {
        const bool has_next = S.next(ui + 1, nxt);
        const char* nA = has_next ? (const char*)g.A + (size_t)nxt.pm * tstepA + (size_t)nxt.kb * kbstep : cA;
        const char* nB = has_next ? (const char*)g.Bt + (size_t)nxt.pn * tstepB + (size_t)nxt.kb * kbstep : cB;
        for (int t = 0; t < nt; t += 2) {
            const bool last = (t == nt - 2);
            const char* a1 = cA + (size_t)(t + 1) * kstep;
            const char* a2 = last ? nA : cA + (size_t)(t + 2) * kstep; const char* b2 = last ? nB : cB + (size_t)(t + 2) * kstep;
            const char* a3 = a2 + kstep; const char* b3 = b2 + kstep;
            PG8_LDB(B0, 0, 0); PG8_LDB(B1, 0, 1); PG8_SCHED; PG8_LDA(At, 0, 0); PG8_STAGE(PG8_SA(1, 1), a1 + hstepA, voffA);
            PG8_WAIT_V(8); PG8_WAIT_L(0); PG8_BAR; PG8_MMA(0, 0, At, B0); PG8_MMA(0, 1, At, B1); PG8_BAR; PG8_SCHED;
            PG8_LDA(At, 0, 1); PG8_STAGE(PG8_SB(0, 0), b2, voffB); PG8_STAGE(PG8_SB(0, 1), b2 + hstepB, voffB); PG8_STAGE(PG8_SA(0, 0), a2, voffA);
            PG8_WAIT_V(8); PG8_WAIT_L(0); PG8_BAR; PG8_MMA(1, 0, At, B0); PG8_MMA(1, 1, At, B1); PG8_BAR; PG8_SCHED;
            PG8_LDB(B0, 1, 0); PG8_LDB(B1, 1, 1); PG8_SCHED; PG8_LDA(At, 1, 0); PG8_STAGE(PG8_SA(0, 1), a2 + hstepA, voffA);
            PG8_WAIT_V(8); PG8_WAIT_L(0); PG8_BAR; PG8_MMA(0, 0, At, B0); PG8_MMA(0, 1, At, B1); PG8_BAR; PG8_SCHED;
            PG8_LDA(At, 1, 1); PG8_STAGE(PG8_SB(1, 0), b3, voffB); PG8_STAGE(PG8_SB(1, 1), b3 + hstepB, voffB); PG8_STAGE(PG8_SA(1, 0), a3, voffA);
            PG8_WAIT_V(8); PG8_WAIT_L(0); PG8_BAR; PG8_MMA(1, 0, At, B0); PG8_MMA(1, 1, At, B1); PG8_BAR; PG8_SCHED;
        }
        if (wr == 0) PG8_BAR;
        E(acc, cur, wr, wc, fr, fq);
        if (!has_next) break;
#pragma unroll
        for (int a = 0; a < 2; ++a)
#pragma unroll
            for (int b = 0; b < 2; ++b)
#pragma unroll
                for (int m = 0; m < 4; ++m)
#pragma unroll
                    for (int n = 0; n < 2; ++n) acc[a][b][m][n] = (f32x4){0.f, 0.f, 0.f, 0.f};
        cur = nxt; cA = nA; cB = nB; ++ui;
        if (wr == 1) PG8_BAR;
    }
    PG8_WAIT_V(0);
    PG8_BAR;
#undef PG8_SA
#undef PG8_SB
#undef PG8_STAGE
#undef PG8_LDA
#undef PG8_LDB
#undef PG8_MMA
#undef PG8_WAIT_V
#undef PG8_WAIT_L
#undef PG8_BAR
#undef PG8_SCHED
}
}

struct Args { const float* in[30]; float* out; unsigned char* ws; int ph_lo, ph_hi; };
enum { I_XP = 0, I_XS, I_SCONV, I_SSSM, I_SHGRN, I_SGLA, I_F1N, I_F1GU, I_F1D, I_MIXN, I_WIN, I_CONVW, I_CONVB, I_DTB, I_ALOG, I_DSKIP, I_MNORM, I_LBL, I_HNORM, I_GWD, I_GBD, I_GNORM,
       I_WBM, I_WBH, I_WBG, I_WOUT, I_F2N, I_F2GU, I_F2D, I_FINN };

__device__ __forceinline__ int map_col(int map, int np) {
    if (map == 0) return np;
    if (map == 1) { const int pn = np >> 8, w = np & 255; return w < 128 ? 128 * pn + w : DFF + 128 * pn + (w - 128); }
    if (np < 2560) return np;
    if (np < PC_GATE) return np + 16;
    if (np < PC_DT) return np + 32;
    if (np < PC_GA) return 2560 + (np - PC_DT);
    if (np < INC) return 9744 + (np - PC_GA);
    return -1;
}
__device__ __forceinline__ void transpose_item(const float* W, int N, const float* kscale, bf16_t* WT, int ldk, int koff, int map, int nblk, LAS float* scr, int item, int lane) {
    const int kb = item / nblk, nb = item % nblk, k0 = 64 * kb, n0 = 32 * nb;
    const int src = map_col(map, n0 + (lane & 31));
#pragma unroll 8
    for (int i = 0; i < 32; ++i) { const int kk = 2 * i + (lane >> 5); float v = 0.f; if (src >= 0) v = W[(size_t)(k0 + kk) * N + src]; if (kscale) v *= kscale[k0 + kk]; scr[kk * 33 + (lane & 31)] = v; }
    LDS_WAIT(); asm volatile("" ::: "memory");
    const int c = lane & 7;
#pragma unroll
    for (int j = 0; j < 4; ++j) { const int n = (lane >> 3) + 8 * j; const LAS float* s = scr + (8 * c) * 33 + n;
        u32x4 o; o.x = pk2(s[0 * 33], s[1 * 33]); o.y = pk2(s[2 * 33], s[3 * 33]); o.z = pk2(s[4 * 33], s[5 * 33]); o.w = pk2(s[6 * 33], s[7 * 33]);
        *(u32x4*)(WT + (size_t)(n0 + n) * ldk + koff + k0 + 8 * c) = o; }
    LDS_WAIT(); asm volatile("" ::: "memory");
}

struct Ctx {
    LAS unsigned char* lds; const Args* a; unsigned char* ws; int tid, lane, wave, G, gw, NGW;
};

__device__ __forceinline__ void phase_prologue(const Args& a, LAS unsigned char* lds) {
    int tid = threadIdx.x; asm volatile("" : "+v"(tid));
    const int lane = tid & 63, wave = __builtin_amdgcn_readfirstlane(tid >> 6), gw = blockIdx.x * 8 + wave, NGW = gridDim.x * 8;
    unsigned char* ws = a.ws;
    LAS float* scr = (LAS float*)(lds + wave * 16384);
    constexpr int IT_GU = 32 * 352, IT_D = 88 * 64, IT_IN = 32 * 504, IT_B = 16 * 64, IT_O = 32 * 64;
    constexpr int IT_LAYER = 2 * IT_GU + 2 * IT_D + IT_IN + 3 * IT_B + IT_O;
    for (int it = gw; it < DEPTH * IT_LAYER; it += NGW) {
        const int l = it / IT_LAYER; int r = it - l * IT_LAYER;
        unsigned char* wl = ws + WS_W + (size_t)l * WL_STRIDE;
        if (r < IT_GU) { transpose_item(a.in[I_F1GU] + (size_t)l * DM * 2 * DFF, 2 * DFF, a.in[I_F1N] + l * DM, (bf16_t*)(wl + WL_GU1), DM, 0, 1, 352, scr, r, lane); continue; } r -= IT_GU;
        if (r < IT_D) { transpose_item(a.in[I_F1D] + (size_t)l * DFF * DM, DM, nullptr, (bf16_t*)(wl + WL_D1), DFF, 0, 0, 64, scr, r, lane); continue; } r -= IT_D;
        if (r < IT_IN) { transpose_item(a.in[I_WIN] + (size_t)l * DM * INC, INC, a.in[I_MIXN] + l * DM, (bf16_t*)(wl + WL_IN), DM, 0, 2, 504, scr, r, lane); continue; } r -= IT_IN;
        if (r < IT_B) { transpose_item(a.in[I_WBM] + (size_t)l * 1024 * DM, DM, nullptr, (bf16_t*)(wl + WL_BR), 3072, 0, 0, 64, scr, r, lane); continue; } r -= IT_B;
        if (r < IT_B) { transpose_item(a.in[I_WBH] + (size_t)l * 1024 * DM, DM, nullptr, (bf16_t*)(wl + WL_BR), 3072, 1024, 0, 64, scr, r, lane); continue; } r -= IT_B;
        if (r < IT_B) { transpose_item(a.in[I_WBG] + (size_t)l * 1024 * DM, DM, nullptr, (bf16_t*)(wl + WL_BR), 3072, 2048, 0, 64, scr, r, lane); continue; } r -= IT_B;
        if (r < IT_O) { transpose_item(a.in[I_WOUT] + (size_t)l * DM * DM, DM, nullptr, (bf16_t*)(wl + WL_OUT), DM, 0, 0, 64, scr, r, lane); continue; } r -= IT_O;
        if (r < IT_GU) { transpose_item(a.in[I_F2GU] + (size_t)l * DM * 2 * DFF, 2 * DFF, a.in[I_F2N] + l * DM, (bf16_t*)(wl + WL_GU2), DM, 0, 1, 352, scr, r, lane); continue; } r -= IT_GU;
        transpose_item(a.in[I_F2D] + (size_t)l * DFF * DM, DM, nullptr, (bf16_t*)(wl + WL_D2), DFF, 0, 0, 64, scr, r, lane);
    }
    float* X = (float*)(ws + WS_X); bf16_t* XB = (bf16_t*)(ws + WS_XB); float* ssq0 = (float*)(ws + WS_CTL + CTL_SSQ);
    for (int r = gw; r < MP; r += NGW) {
        const float* src = r < NPROMPT ? a.in[I_XP] + (size_t)r * DM : (r < NTOK ? a.in[I_XS] + (size_t)(r - NPROMPT) * DM : nullptr);
        float ss = 0.f;
#pragma unroll
        for (int j = 0; j < 8; ++j) { f32x4 v = (f32x4){0.f, 0.f, 0.f, 0.f}; if (src) v = *(const f32x4*)(src + 4 * lane + 256 * j);
            *(f32x4*)(X + (size_t)r * DM + 4 * lane + 256 * j) = v; ss += (v[0] * v[0] + v[1] * v[1]) + (v[2] * v[2] + v[3] * v[3]);
            u32x2 w; w.x = pk2(v[0], v[1]); w.y = pk2(v[2], v[3]); *(u32x2*)(XB + (size_t)r * DM + 4 * lane + 256 * j) = w; }
        ss = wave_sum(ss); if (lane == 0) ssq0[r] = ss;
        if (r >= NTOK) { bf16_t* y = (bf16_t*)(ws + WS_Y) + (size_t)r * 3072;
#pragma unroll
            for (int j = 0; j < 6; ++j) *(u32x4*)(y + 8 * lane + 512 * j) = (u32x4){0u, 0u, 0u, 0u}; }
    }
    float* LB = (float*)(ws + WS_LB);
    for (int c = gw * 64 + lane; c < 1024; c += NGW * 64) {
        float mx = -1e30f; for (int l = 0; l < DEPTH; ++l) mx = fmaxf(mx, a.in[I_LBL][l * 1024 + c]);
        float den = 0.f; for (int l = 0; l < DEPTH; ++l) den += expf(a.in[I_LBL][l * 1024 + c] - mx);
        float cum = 0.f; const float sm0 = expf(a.in[I_LBL][c] - mx) / den;
        for (int l = 0; l < DEPTH; ++l) { cum += expf(a.in[I_LBL][l * 1024 + c] - mx) / den; LB[l * 1024 + c] = cum - sm0; }
    }
}

__device__ __forceinline__ void unpack8(const u32x4 w, float (&x)[8]) {
#pragma unroll
    for (int j = 0; j < 4; ++j) { x[2 * j] = bf2f(w[j] & 0xffffu); x[2 * j + 1] = bf2f(w[j] >> 16); }
}
__device__ __forceinline__ void phase_prep(const Args& a, int l, LAS unsigned char* lds) {
    int tid = threadIdx.x; asm volatile("" : "+v"(tid));
    const int lane = tid & 63, wave = __builtin_amdgcn_readfirstlane(tid >> 6), gw = blockIdx.x * 8 + wave, NGW = gridDim.x * 8;
    unsigned char* ws = a.ws;
    const bf16_t* PROJ = (const bf16_t*)(ws + WS_PROJ); bf16_t* XC = (bf16_t*)(ws + WS_XC); float* DT = (float*)(ws + WS_DT); float* LGA = (float*)(ws + WS_LGA);
    LAS float* swd = (LAS float*)lds;
    for (int i = tid; i < 16 * 512; i += 512) swd[i] = a.in[I_GWD][(size_t)l * 16 * 512 + i];
    for (int i = tid; i < 512; i += 512) swd[8192 + i] = a.in[I_GBD][l * 512 + i];
    __syncthreads();
    const float* cw = a.in[I_CONVW] + (size_t)l * 4 * 1536; const float* cb = a.in[I_CONVB] + l * 1536;
    for (int r = gw; r < NTOK; r += NGW) {
        const bool samp = r >= NPROMPT; const int t = samp ? 0 : (r & (SEQ - 1)), s = r - NPROMPT, b = r >> 11;
        const bf16_t* prow = PROJ + (size_t)r * INP;
#pragma unroll 1
        for (int i = 0; i < 3; ++i) {
            const int ch = lane * 8 + 512 * i;
            float c[8], x[8];
            { const f32x4 b0 = *(const f32x4*)(cb + ch), b1 = *(const f32x4*)(cb + ch + 4);
#pragma unroll
              for (int j = 0; j < 4; ++j) { c[j] = b0[j]; c[4 + j] = b1[j]; } }
            unpack8(*(const u32x4*)(prow + PC_XBC + ch), x);
            { const f32x4 w0 = *(const f32x4*)(cw + 3 * 1536 + ch), w1 = *(const f32x4*)(cw + 3 * 1536 + ch + 4);
#pragma unroll
              for (int j = 0; j < 4; ++j) { c[j] += w0[j] * x[j]; c[4 + j] += w1[j] * x[4 + j]; } }
            if (samp) { float* op = a.out + O_CS + (((size_t)l * NSAMP + s) * 3 + 2) * 1536 + ch; *(f32x4*)op = (f32x4){x[0], x[1], x[2], x[3]}; *(f32x4*)(op + 4) = (f32x4){x[4], x[5], x[6], x[7]}; }
            else if (t >= SEQ - 3) { float* op = a.out + O_CP + (((size_t)l * NB + b) * 3 + (t - (SEQ - 3))) * 1536 + ch; *(f32x4*)op = (f32x4){x[0], x[1], x[2], x[3]}; *(f32x4*)(op + 4) = (f32x4){x[4], x[5], x[6], x[7]}; }
#pragma unroll
            for (int k = 1; k <= 3; ++k) {
                if (samp) { const float* sp = a.in[I_SCONV] + (((size_t)l * NSAMP + s) * 3 + (3 - k)) * 1536 + ch; const f32x4 p0 = *(const f32x4*)sp, p1 = *(const f32x4*)(sp + 4);
#pragma unroll
                    for (int j = 0; j < 4; ++j) { x[j] = p0[j]; x[4 + j] = p1[j]; }
                    if (k <= 2) { float* op = a.out + O_CS + (((size_t)l * NSAMP + s) * 3 + (2 - k)) * 1536 + ch; *(f32x4*)op = p0; *(f32x4*)(op + 4) = p1; } }
                else if (t - k >= 0) unpack8(*(const u32x4*)(prow - (size_t)k * INP + PC_XBC + ch), x);
                else {
#pragma unroll
                    for (int j = 0; j < 8; ++j) x[j] = 0.f; }
                const f32x4 w0 = *(const f32x4*)(cw + (3 - k) * 1536 + ch), w1 = *(const f32x4*)(cw + (3 - k) * 1536 + ch + 4);
#pragma unroll
                for (int j = 0; j < 4; ++j) { c[j] += w0[j] * x[j]; c[4 + j] += w1[j] * x[4 + j]; }
            }
            u32x4 w; w.x = pk2(siluf_(c[0]), siluf_(c[1])); w.y = pk2(siluf_(c[2]), siluf_(c[3])); w.z = pk2(siluf_(c[4]), siluf_(c[5])); w.w = pk2(siluf_(c[6]), siluf_(c[7]));
            *(u32x4*)(XC + (size_t)r * 1536 + ch) = w;
        }
        if (lane < 16) DT[(size_t)r * 16 + lane] = softplusf_(bf2f(prow[PC_DT + lane]) + a.in[I_DTB][l * 16 + lane]);
        { float ga[16];
          unpack8(*(const u32x4*)(prow + PC_GA), *(float(*)[8])&ga[0]); unpack8(*(const u32x4*)(prow + PC_GA + 8), *(float(*)[8])&ga[8]);
          float pre[8];
#pragma unroll
          for (int e = 0; e < 8; ++e) pre[e] = swd[8192 + lane * 8 + e];
#pragma unroll
          for (int i = 0; i < 16; ++i)
#pragma unroll
              for (int e = 0; e < 8; ++e) pre[e] += ga[i] * swd[i * 512 + lane * 8 + e];
          float lo[8];
#pragma unroll
          for (int e = 0; e < 8; ++e) lo[e] = -(fmaxf(-pre[e], 0.f) + log1pf(__expf(-fabsf(pre[e])))) * (1.0f / 16.0f);
          float* op = LGA + (size_t)r * 512 + lane * 8;
          *(f32x4*)op = (f32x4){lo[0], lo[1], lo[2], lo[3]}; *(f32x4*)(op + 4) = (f32x4){lo[4], lo[5], lo[6], lo[7]}; }
    }
}

constexpr int TCH = 16;
struct ScanUnit { int mix, seq, h, j0, L, row0; bool samp; };
__device__ __forceinline__ void scan_unit(const Args& a, int l, const ScanUnit& U, LAS unsigned char* lds, const int tid, const int lane, const int wave) {
    unsigned char* ws = a.ws;
    const bf16_t* PROJ = (const bf16_t*)(ws + WS_PROJ); const bf16_t* XC = (const bf16_t*)(ws + WS_XC); const float* DT = (const float*)(ws + WS_DT); const float* LGA = (const float*)(ws + WS_LGA);
    float* O = (float*)(ws + WS_O); const float* LB = (const float*)(ws + WS_LB) + l * 1024;
    LAS float* sq = (LAS float*)lds;
    LAS float* sk = sq + 2 * TCH * 128;
    LAS float* sd = sk + 2 * TCH * 128;
    LAS float* sv = sd + 2 * TCH * 128;
    LAS float* sx = sv + 2 * TCH * 64;
    LAS float* red = sx + 2 * TCH * 64;
    const int mix = U.mix, h = U.h, j0 = U.j0;
    const int d = tid & 127;
    float cA = 0.f, cB = 0.f;
    if (mix == 0) cA = -__expf(a.in[I_ALOG][l * 16 + h]);
    if (mix == 1) cA = LB[h * 128 + d];
    const float dskip = (mix == 0) ? a.in[I_DSKIP][l * 16 + h] : 0.f;
    (void)cB;
    float S[16];
    size_t sbase; int sstride_dk, sstride_dv;
    const float* sin = nullptr; float* sout;
    if (mix == 0) { sstride_dk = 1; sstride_dv = 128;
        if (U.samp) { sbase = (((size_t)l * NSAMP + U.seq) * 16 + h) * 8192; sin = a.in[I_SSSM] + sbase; sout = a.out + O_SS + sbase; }
        else { sbase = (((size_t)l * NB + U.seq) * 16 + h) * 8192; sout = a.out + O_SP + sbase; } }
    else if (mix == 1) { sstride_dk = 128; sstride_dv = 1;
        if (U.samp) { sbase = (((size_t)l * NSAMP + U.seq) * 8 + h) * 16384; sin = a.in[I_SHGRN] + sbase; sout = a.out + O_HS + sbase; }
        else { sbase = (((size_t)l * NB + U.seq) * 8 + h) * 16384; sout = a.out + O_HP + sbase; } }
    else { sstride_dk = 256; sstride_dv = 1;
        if (U.samp) { sbase = (((size_t)l * NSAMP + U.seq) * 4 + h) * 32768; sin = a.in[I_SGLA] + sbase; sout = a.out + O_GS + sbase; }
        else { sbase = (((size_t)l * NB + U.seq) * 4 + h) * 32768; sout = a.out + O_GP + sbase; } }
    const size_t soff = (size_t)(wave * 16) * sstride_dk + (size_t)(j0 + lane) * sstride_dv;
#pragma unroll
    for (int i = 0; i < 16; ++i) S[i] = sin ? sin[soff + (size_t)i * sstride_dk] : 0.f;

    const int nch = (U.L + TCH - 1) / TCH;
    unsigned r0[4], r1[4]; float rx[4]; unsigned rv[2]; float rdt[2];
#define LOAD_RAW(c) do { \
    _Pragma("unroll") \
        for (int ii = 0; ii < 4; ++ii) { const int tk = (tid >> 7) + 4 * ii, t = (c) * TCH + tk; r0[ii] = 0; r1[ii] = 0; rx[ii] = 0.f; \
            if (t < U.L) { const size_t r = (size_t)U.row0 + t; \
                if (mix == 0) { const int grp = h >> 3; r0[ii] = XC[r * 1536 + 1280 + grp * 128 + d]; r1[ii] = XC[r * 1536 + 1024 + grp * 128 + d]; rx[ii] = DT[r * 16 + h]; } \
                else if (mix == 1) { r0[ii] = PROJ[r * INP + PC_HQ + h * 128 + d]; r1[ii] = PROJ[r * INP + PC_HF + h * 128 + d]; } \
                else { r0[ii] = PROJ[r * INP + PC_GQ + h * 128 + d]; r1[ii] = PROJ[r * INP + PC_GK + h * 128 + d]; rx[ii] = LGA[r * 512 + h * 128 + d]; } } } \
    _Pragma("unroll") \
        for (int ii = 0; ii < 2; ++ii) { const int tk = wave + 8 * ii, t = (c) * TCH + tk; rv[ii] = 0; rdt[ii] = 0.f; \
            if (t < U.L) { const size_t r = (size_t)U.row0 + t; \
                if (mix == 0) { rv[ii] = XC[r * 1536 + h * 64 + lane]; rdt[ii] = DT[r * 16 + h]; } \
                else if (mix == 1) rv[ii] = PROJ[r * INP + PC_HI + h * 128 + j0 + lane]; \
                else rv[ii] = PROJ[r * INP + PC_GV + h * 256 + j0 + lane]; } } \
} while (0)
#define STORE_LDS(p) do { \
    _Pragma("unroll") \
        for (int ii = 0; ii < 4; ++ii) { const int tk = (tid >> 7) + 4 * ii; const int o = ((p) * TCH + tk) * 128 + d; const float v0 = bf2f(r0[ii]), v1 = bf2f(r1[ii]); \
            if (mix == 0) { sq[o] = v0; sk[o] = v1; sd[o] = __expf(rx[ii] * cA); } \
            else if (mix == 1) { sq[o] = siluf_(v0) * 0.08838834764831845f; const float sg = sigmoidf_(v1); sd[o] = cA + (1.f - cA) * sg; sk[o] = (1.f - cA) * fast_rcp(1.f + __expf(v1)); } \
            else { sq[o] = v0 * 0.08838834764831845f; sk[o] = v1; sd[o] = __expf(rx[ii]); } } \
    _Pragma("unroll") \
        for (int ii = 0; ii < 2; ++ii) { const int tk = wave + 8 * ii; const int o = ((p) * TCH + tk) * 64 + lane; const float v = bf2f(rv[ii]); \
            if (mix == 0) { sv[o] = v * rdt[ii]; sx[o] = v; } else { sv[o] = v; sx[o] = 0.f; } } \
} while (0)
    __syncthreads();
    LOAD_RAW(0); STORE_LDS(0);
    __syncthreads();
    for (int c = 0; c < nch; ++c) {
        const int p = c & 1; const int ntok = min(TCH, U.L - c * TCH);
        if (c + 1 < nch) LOAD_RAW(c + 1);
        for (int tk = 0; tk < ntok; ++tk) {
            const float v = sv[(p * TCH + tk) * 64 + lane]; float accv = 0.f;
            const LAS f32x4* q4 = (const LAS f32x4*)(sq + (p * TCH + tk) * 128 + wave * 16);
            const LAS f32x4* k4 = (const LAS f32x4*)(sk + (p * TCH + tk) * 128 + wave * 16);
            const LAS f32x4* d4 = (const LAS f32x4*)(sd + (p * TCH + tk) * 128 + wave * 16);
#pragma unroll
            for (int i4 = 0; i4 < 4; ++i4) { const f32x4 qq = q4[i4], kk = k4[i4], dd = d4[i4];
#pragma unroll
                for (int e = 0; e < 4; ++e) { S[i4 * 4 + e] = dd[e] * S[i4 * 4 + e] + kk[e] * v; accv += qq[e] * S[i4 * 4 + e]; } }
            red[(tk * 8 + wave) * 64 + lane] = accv;
        }
        __syncthreads();
#pragma unroll
        for (int ii = 0; ii < 2; ++ii) { const int tk = wave + 8 * ii;
            if (tk < ntok) { float o = 0.f;
#pragma unroll
                for (int gq = 0; gq < 8; ++gq) o += red[(tk * 8 + gq) * 64 + lane];
                o += dskip * sx[(p * TCH + tk) * 64 + lane];
                const size_t r = (size_t)U.row0 + c * TCH + tk;
                const int col = mix == 0 ? h * 64 + lane : (mix == 1 ? 1024 + h * 128 + j0 + lane : 2048 + h * 256 + j0 + lane);
                O[r * 3072 + col] = o; } }
        if (c + 1 < nch) STORE_LDS(p ^ 1);
        __syncthreads();
    }
#pragma unroll
    for (int i = 0; i < 16; ++i) sout[soff + (size_t)i * sstride_dk] = S[i];
}
#undef LOAD_RAW
#undef STORE_LDS
__device__ __forceinline__ void phase_scan(const Args& a, int l, LAS unsigned char* lds) {
    int tid = threadIdx.x; asm volatile("" : "+v"(tid));
    const int lane = tid & 63, wave = __builtin_amdgcn_readfirstlane(tid >> 6), G = gridDim.x;
    const int w = blockIdx.x;
    constexpr int NPU = 192, NSU = 6144;
    const int nsw = G - NPU > 0 ? G - NPU : G;
    if (w < NPU) { const int mix = w / 64, rem = w % 64, b = rem / 16, hs = rem % 16; ScanUnit U; U.mix = mix; U.seq = b; U.samp = false; U.L = SEQ; U.row0 = b * SEQ;
        if (mix == 0) { U.h = hs; U.j0 = 0; } else if (mix == 1) { U.h = hs >> 1; U.j0 = 64 * (hs & 1); } else { U.h = hs >> 2; U.j0 = 64 * (hs & 3); }
        scan_unit(a, l, U, lds, tid, lane, wave); }
    const int sw = (G > NPU) ? w - NPU : w;
    if (sw >= 0) for (int su = sw; su < NSU; su += nsw) { const int mix = su / 2048, rem = su % 2048, s = rem / 16, hs = rem % 16; ScanUnit U; U.mix = mix; U.seq = s; U.samp = true; U.L = 1; U.row0 = NPROMPT + s;
        if (mix == 0) { U.h = hs; U.j0 = 0; } else if (mix == 1) { U.h = hs >> 1; U.j0 = 64 * (hs & 1); } else { U.h = hs >> 2; U.j0 = 64 * (hs & 3); }
        scan_unit(a, l, U, lds, tid, lane, wave); }
}

__device__ __forceinline__ void phase_post(const Args& a, int l) {
    int tid = threadIdx.x; asm volatile("" : "+v"(tid));
    const int lane = tid & 63, wave = __builtin_amdgcn_readfirstlane(tid >> 6), gw = blockIdx.x * 8 + wave, NGW = gridDim.x * 8;
    unsigned char* ws = a.ws;
    const bf16_t* PROJ = (const bf16_t*)(ws + WS_PROJ); const float* O = (const float*)(ws + WS_O); bf16_t* Y = (bf16_t*)(ws + WS_Y);
    const float* mnw = a.in[I_MNORM] + l * 1024; const float* hnw = a.in[I_HNORM] + l * 128; const float* gnw = a.in[I_GNORM] + l * 256;
    for (int r = gw; r < NTOK; r += NGW) {
        const float* orow = O + (size_t)r * 3072; const bf16_t* prow = PROJ + (size_t)r * INP; bf16_t* yrow = Y + (size_t)r * 3072;
#pragma unroll
        for (int g = 0; g < 2; ++g) { const int c0 = g * 512 + lane * 8; float y[8]; float ss = 0.f;
            const f32x4 o0 = *(const f32x4*)(orow + c0), o1 = *(const f32x4*)(orow + c0 + 4); const u32x4 zw = *(const u32x4*)(prow + PC_Z + c0);
#pragma unroll
            for (int j = 0; j < 4; ++j) { y[2 * j] = (j < 2 ? o0[2 * j] : o1[2 * j - 4]) * siluf_(bf2f(zw[j] & 0xffffu)); y[2 * j + 1] = (j < 2 ? o0[2 * j + 1] : o1[2 * j - 3]) * siluf_(bf2f(zw[j] >> 16)); }
#pragma unroll
            for (int j = 0; j < 8; ++j) ss += y[j] * y[j];
            ss = wave_sum(ss); const float rs = rsqrtf(ss * (1.0f / 512.0f) + EPS);
            u32x4 w; w.x = pk2(y[0] * rs * mnw[c0], y[1] * rs * mnw[c0 + 1]); w.y = pk2(y[2] * rs * mnw[c0 + 2], y[3] * rs * mnw[c0 + 3]); w.z = pk2(y[4] * rs * mnw[c0 + 4], y[5] * rs * mnw[c0 + 5]); w.w = pk2(y[6] * rs * mnw[c0 + 6], y[7] * rs * mnw[c0 + 7]);
            *(u32x4*)(yrow + c0) = w; }
#pragma unroll
        for (int hh = 0; hh < 8; ++hh) { const int c0 = hh * 128 + lane * 2; const f32x2 o = *(const f32x2*)(orow + 1024 + c0); const unsigned gwv = *(const unsigned*)(prow + PC_HG + c0);
            float ss = wave_sum(o[0] * o[0] + o[1] * o[1]); const float rs = rsqrtf(ss * (1.0f / 128.0f) + EPS);
            *(unsigned*)(yrow + 1024 + c0) = pk2(o[0] * rs * hnw[lane * 2] * siluf_(bf2f(gwv & 0xffffu)), o[1] * rs * hnw[lane * 2 + 1] * siluf_(bf2f(gwv >> 16))); }
#pragma unroll
        for (int hh = 0; hh < 4; ++hh) { const int c0 = hh * 256 + lane * 4; const f32x4 o = *(const f32x4*)(orow + 2048 + c0); const u32x2 gwv = *(const u32x2*)(prow + PC_GG + c0);
            float ss = wave_sum((o[0] * o[0] + o[1] * o[1]) + (o[2] * o[2] + o[3] * o[3])); const float rs = rsqrtf(ss * (1.0f / 256.0f) + EPS);
            u32x2 w; w.x = pk2(o[0] * rs * gnw[lane * 4] * siluf_(bf2f(gwv.x & 0xffffu)), o[1] * rs * gnw[lane * 4 + 1] * siluf_(bf2f(gwv.x >> 16)));
            w.y = pk2(o[2] * rs * gnw[lane * 4 + 2] * siluf_(bf2f(gwv.y & 0xffffu)), o[3] * rs * gnw[lane * 4 + 3] * siluf_(bf2f(gwv.y >> 16)));
            *(u32x2*)(yrow + 2048 + c0) = w; }
    }
}

__device__ __forceinline__ void phase_final(const Args& a) {
    int tid = threadIdx.x; asm volatile("" : "+v"(tid));
    const int lane = tid & 63, wave = __builtin_amdgcn_readfirstlane(tid >> 6), gw = blockIdx.x * 8 + wave, NGW = gridDim.x * 8;
    const float* X = (const float*)(a.ws + WS_X); const float* ssq = (const float*)(a.ws + WS_CTL + CTL_SSQ) + (size_t)(3 * DEPTH) * MP; const float* fw = a.in[I_FINN];
    for (int r = gw; r < NTOK; r += NGW) {
        const float rs = rsqrtf(ssq[r] * (1.0f / DM) + EPS);
        float* o = r < NPROMPT ? a.out + O_YP + (size_t)r * DM : a.out + O_YS + (size_t)(r - NPROMPT) * DM;
#pragma unroll
        for (int j = 0; j < 8; ++j) { const f32x4 v = *(const f32x4*)(X + (size_t)r * DM + 4 * lane + 256 * j), w = *(const f32x4*)(fw + 4 * lane + 256 * j);
            *(f32x4*)(o + 4 * lane + 256 * j) = v * rs * w; }
    }
}

__global__ void __launch_bounds__(512, 2) fwd(Args args) {
    extern __shared__ __attribute__((aligned(16))) unsigned char lds_raw[];
    LAS unsigned char* lds = (LAS unsigned char*)lds_raw;
    volatile LAS unsigned* MISC = (volatile LAS unsigned*)(lds + MISC_OFF);
    const int G = gridDim.x;
    unsigned char* ws = args.ws;
    unsigned* ctl = (unsigned*)(ws + WS_CTL);
    for (int u = threadIdx.x; u < (LDS_BYTES - 131072) / 4; u += 512) ((LAS unsigned*)(lds + 131072))[u] = 0u;
    __syncthreads();
    XcdBarrier bar; bar.bar = ctl + CW_BAR; bar.x = 0; bar.st = nullptr;
    const int lo = args.ph_lo, hi = args.ph_hi;
    const bool multi = (hi - lo) > 1;
    if (multi) bar = xcd_barrier_post(ctl + CW_BAR, MISC + 8);
#define IN(k) (lo <= (k) && (k) < hi)
#define SEAM(k) do { if (IN(k) && IN((k) + 1)) xcd_barrier(bar); } while (0)
    float* ssq = (float*)(ws + WS_CTL + CTL_SSQ);
    float* X = (float*)(ws + WS_X); bf16_t* XB = (bf16_t*)(ws + WS_XB); bf16_t* ACT = (bf16_t*)(ws + WS_ACT); bf16_t* PROJ = (bf16_t*)(ws + WS_PROJ);
    bf16_t* Y = (bf16_t*)(ws + WS_Y); float* PART = (float*)(ws + WS_PART); bf16_t* MRG = (bf16_t*)(ws + WS_MRG);
    int ph = 0;
    if (PHON(0) && IN(ph)) { phase_prologue(args, lds); } SEAM(ph); ++ph;
    for (int it = 0; it < 3 * DEPTH; ++it) {
        const int l = it / 3, kind = it - 3 * l;
        unsigned char* wl = ws + WS_W + (size_t)l * WL_STRIDE;
        if (kind != 1) {
            const int si = 3 * l + (kind == 0 ? 0 : 2);
            if (PHON(1) && IN(ph)) { pg8::Gemm g{XB, (const bf16_t*)(wl + (kind == 0 ? WL_GU1 : WL_GU2)), DM, DM, DM}; pg8::Order<1> S; S.init(MP / 256, 2 * DFF / 256, G, (int)blockIdx.x);
                pg8::EpiSwiGLU E{ACT, ssq + (size_t)si * MP}; pg8::gemm_phase(lds, g, S, E); } SEAM(ph); ++ph;
            if (PHON(2) && IN(ph)) { pg8::Gemm g{ACT, (const bf16_t*)(wl + (kind == 0 ? WL_D1 : WL_D2)), DFF, DFF, DFF}; pg8::Order<1> S; S.init(MP / 256, DM / 256, G, (int)blockIdx.x);
                pg8::EpiResid E{X, XB, ssq + (size_t)(si + 1) * MP, 0.5f}; pg8::gemm_phase(lds, g, S, E); } SEAM(ph); ++ph;
        } else {
            if (PHON(3) && IN(ph)) { pg8::Gemm g{XB, (const bf16_t*)(wl + WL_IN), DM, DM, DM}; pg8::Order<1> S; S.init(MP / 256, INP / 256, G, (int)blockIdx.x);
                pg8::EpiProj E{PROJ, ssq + (size_t)(3 * l + 1) * MP}; pg8::gemm_phase(lds, g, S, E); } SEAM(ph); ++ph;
            if (PHON(4) && IN(ph)) { phase_prep(args, l, lds); } SEAM(ph); ++ph;
            if (PHON(5) && IN(ph)) { phase_scan(args, l, lds); } SEAM(ph); ++ph;
            if (PHON(6) && IN(ph)) { phase_post(args, l); } SEAM(ph); ++ph;
            if (PHON(7) && IN(ph)) { pg8::Gemm g{Y, (const bf16_t*)(wl + WL_BR), 3072, 3072, 1024}; pg8::Order<3> S; S.init(MP / 256, DM / 256, G, (int)blockIdx.x);
                pg8::EpiBranch E{PROJ, PART, MRG}; pg8::gemm_phase(lds, g, S, E); } SEAM(ph); ++ph;
            if (PHON(8) && IN(ph)) { pg8::Gemm g{MRG, (const bf16_t*)(wl + WL_OUT), DM, DM, DM}; pg8::Order<1> S; S.init(MP / 256, DM / 256, G, (int)blockIdx.x);
                pg8::EpiResid E{X, XB, ssq + (size_t)(3 * l + 2) * MP, 1.0f}; pg8::gemm_phase(lds, g, S, E); } SEAM(ph); ++ph;
        }
    }
    if (PHON(9) && IN(ph)) { phase_final(args); } ++ph;
#undef IN
#undef SEAM
}
constexpr int N_PHASES = 1 + DEPTH * 10 + 1;

extern "C" void kernel_launch(void* const* d_in, const int* in_sizes, int n_in, void* d_out, int out_size, void* d_ws, size_t ws_size, hipStream_t stream) {
    static int grid = 0;
    if (grid == 0) {
        if (n_in != 30 || (size_t)out_size != O_END || ws_size < WS_END) { fprintf(stderr, "kernel_launch: unexpected problem: n_in %d out %d ws %zu (need %zu)\n", n_in, out_size, ws_size, (size_t)WS_END); grid = -1; return; }
        int dev = 0, cus = 0, per_cu = 0;
        if (hipGetDevice(&dev) != hipSuccess || hipDeviceGetAttribute(&cus, hipDeviceAttributeMultiprocessorCount, dev) != hipSuccess) { grid = -1; return; }
        if (hipFuncSetAttribute((const void*)fwd, hipFuncAttributeMaxDynamicSharedMemorySize, LDS_BYTES) != hipSuccess) { fprintf(stderr, "kernel_launch: hipFuncSetAttribute failed\n"); grid = -1; return; }
        if (hipOccupancyMaxActiveBlocksPerMultiprocessor(&per_cu, (const void*)fwd, 512, LDS_BYTES) != hipSuccess || per_cu < 1) fprintf(stderr, "kernel_launch: occupancy query reports %d\n", per_cu);
        (void)hipGetLastError();
        grid = cus;
    }
    if (grid < 0) return;
    (void)hipMemsetAsync((char*)d_ws + WS_CTL, 0, CTL_ZERO_BYTES, stream);
    Args a{};
    for (int i = 0; i < 30; ++i) a.in[i] = (const float*)d_in[i];
    a.out = (float*)d_out; a.ws = (unsigned char*)d_ws;
#if MK_PER_PHASE
    for (int p = 0; p < N_PHASES; ++p) { a.ph_lo = p; a.ph_hi = p + 1; hipLaunchKernelGGL(fwd, dim3(grid), dim3(512), LDS_BYTES, stream, a); }
#else
    a.ph_lo = 0; a.ph_hi = N_PHASES; hipLaunchKernelGGL(fwd, dim3(grid), dim3(512), LDS_BYTES, stream, a);
#endif
}
```

```cpp
#include <hip/hip_runtime.h>
#include <cstdio>
#include <cstdint>

#ifndef PHMASK
#define PHMASK 0xFFFF
#endif
#define PHON(k) ((PHMASK >> (k)) & 1)
#ifndef MK_PER_PHASE
#define MK_PER_PHASE 0
#endif

#define LAS __attribute__((address_space(3)))
#define GAS __attribute__((address_space(1)))
typedef unsigned short bf16_t;
typedef short bf16x8 __attribute__((ext_vector_type(8)));
typedef float f32x4 __attribute__((ext_vector_type(4)));
typedef float f32x2 __attribute__((ext_vector_type(2)));
typedef unsigned u32x4 __attribute__((ext_vector_type(4)));
typedef unsigned u32x2 __attribute__((ext_vector_type(2)));

constexpr int DM = 2048, DFF = 5632, SEQ = 2048, NB = 4, NPROMPT = NB * SEQ, NSAMP = 128, NTOK = NPROMPT + NSAMP, MP = 8448  , DEPTH = 2;
constexpr int INC = 15904, INP = 16128;
constexpr float EPS = 1e-6f;
constexpr int PC_Z = 0, PC_XBC = 1024, PC_HQ = 2560, PC_HF = 3584, PC_HI = 4608, PC_HG = 5632, PC_GQ = 6656, PC_GK = 7168, PC_GV = 7680, PC_GG = 8704, PC_GATE = 9728, PC_DT = 15872, PC_GA = 15888;
constexpr size_t O_YP = 0, O_YS = 16777216, O_CP = 17039360, O_SP = 17076224, O_HP = 18124800, O_GP = 19173376, O_CS = 20221952, O_SS = 21401600, O_HS = 54956032, O_GS = 88510464, O_END = 122064896;

constexpr size_t MiB = 1u << 20;
constexpr size_t WS_CTL = 0, CTL_ZERO_BYTES = 1 * MiB;
constexpr size_t WS_LB = 1 * MiB, WS_DT = 2 * MiB, WS_LGA = 3 * MiB, WS_XC = 20 * MiB, WS_X = 45 * MiB, WS_XB = 111 * MiB, WS_ACT = 144 * MiB, WS_PROJ = 235 * MiB,
                 WS_O = 495 * MiB, WS_Y = 594 * MiB, WS_PART = 644 * MiB, WS_MRG = 710 * MiB, WS_W = 743 * MiB;
constexpr size_t WL_GU1 = 0, WL_D1 = 44 * MiB, WL_IN = 66 * MiB, WL_BR = 129 * MiB, WL_OUT = 141 * MiB, WL_GU2 = 149 * MiB, WL_D2 = 193 * MiB, WL_STRIDE = 215 * MiB;
constexpr size_t WS_END = WS_W + 2 * WL_STRIDE;
constexpr int CW_BAR = 4096;
constexpr size_t CTL_SSQ = 512 * 1024;
constexpr int LDS_BYTES = 147456;
constexpr int MISC_OFF = 131072 + 320;

__device__ __forceinline__ float bf2f(unsigned b) { return __uint_as_float(b << 16); }
__device__ __forceinline__ unsigned f2bf(float f) { unsigned u = __float_as_uint(f); return (u + 0x7fffu + ((u >> 16) & 1u)) >> 16; }
__device__ __forceinline__ unsigned pk2(float lo, float hi) { return f2bf(lo) | (f2bf(hi) << 16); }
__device__ __forceinline__ unsigned cvt_pk_bf16(float lo, float hi) { unsigned r; asm volatile("v_cvt_pk_bf16_f32 %0, %1, %2" : "=v"(r) : "v"(lo), "v"(hi)); return r; }
__device__ __forceinline__ float fast_rcp(float x) { return __builtin_amdgcn_rcpf(x); }
__device__ __forceinline__ float sigmoidf_(float x) { return fast_rcp(1.0f + __expf(-x)); }
__device__ __forceinline__ float siluf_(float x) { return x * sigmoidf_(x); }
__device__ __forceinline__ float softplusf_(float x) { return x > 20.f ? x : log1pf(__expf(x)); }
__device__ __forceinline__ float wave_sum(float v) {
#pragma unroll
    for (int o = 1; o < 64; o <<= 1) v += __shfl_xor(v, o);
    return v;
}
#define LDS_WAIT() asm volatile("s_waitcnt lgkmcnt(0)" ::: "memory")
#define VM_WAIT() asm volatile("s_waitcnt vmcnt(0)" ::: "memory")

#define XB_TMO      128
#define XB_XCNT(j)  (256  + 64 * (j))
#define XB_XSUB(j)  (1280 + 64 * (j))
#define XB_XGEN(j)  (2304 + 64 * (j))
#define XB_TOP      3328
#define XB_TOPGEN   3392
#define XCD_BAR_WORDS 3456
#define XB_SPIN_CAP (1u << 18)
__device__ __forceinline__ unsigned xb_ld(unsigned* p)              { return __hip_atomic_load(p, __ATOMIC_RELAXED, __HIP_MEMORY_SCOPE_AGENT); }
__device__ __forceinline__ unsigned xb_add(unsigned* p, unsigned v) { return __hip_atomic_fetch_add(p, v, __ATOMIC_RELAXED, __HIP_MEMORY_SCOPE_AGENT); }
__device__ __forceinline__ unsigned xb_xcc_id() { return (unsigned)__builtin_amdgcn_s_getreg((3 << 11) | 20) & 0xFu; }
#define XB_SPIN(cond, bar) do { unsigned _sp = 0; while (cond) { __builtin_amdgcn_s_sleep(1); \
    if ((++_sp & 255u) == 0u) { if (xb_ld(&(bar)[XB_TMO])) break; if (_sp > XB_SPIN_CAP) { atomicAdd(&(bar)[XB_TMO], 1u); break; } } } } while (0)
struct XcdBarrier { unsigned* bar; unsigned x; volatile LAS unsigned* st; };
__device__ __forceinline__ XcdBarrier xcd_barrier_post(unsigned* bar, volatile LAS unsigned* st) {
    XcdBarrier b; b.bar = bar; b.x = xb_xcc_id(); b.st = st;
    if (threadIdx.x == 0) (void)xb_add(&bar[XB_XCNT(b.x)], 1u);
    return b;
}
__device__ __forceinline__ void xcd_barrier_complete(unsigned* bar, unsigned x, unsigned& nloc, unsigned& nx) {
    const unsigned G = gridDim.x * gridDim.y * gridDim.z;
    unsigned sum, cnt, mine, sp = 0u;
    for (;;) {
        sum = 0u; cnt = 0u; mine = 0u;
#pragma unroll
        for (unsigned j = 0; j < 16; ++j) { const unsigned c = xb_ld(&bar[XB_XCNT(j)]); sum += c; cnt += (c > 0u) ? 1u : 0u; mine = (j == x) ? c : mine; }
        if (sum == G) break;
        __builtin_amdgcn_s_sleep(1);
        if ((++sp & 255u) == 0u) { if (xb_ld(&bar[XB_TMO])) break; if (sp > XB_SPIN_CAP) { atomicAdd(&bar[XB_TMO], 1u); break; } }
    }
    nloc = mine > 0u ? mine : 1u; nx = cnt > 0u ? cnt : 1u;
}
__device__ __forceinline__ void xcd_barrier(const XcdBarrier& b) {
    asm volatile("s_waitcnt vmcnt(0)" ::: "memory");
    __syncthreads();
    if (threadIdx.x == 0) {
        unsigned* bar = b.bar;
        __builtin_amdgcn_s_waitcnt(0);
        unsigned nloc = b.st[0], nx = b.st[1];
        if (nloc == 0u) { xcd_barrier_complete(bar, b.x, nloc, nx); b.st[0] = nloc; b.st[1] = nx; }
        const unsigned old = xb_add(&bar[XB_XSUB(b.x)], 1u);
        const unsigned gen = old / nloc;
        if (old + 1u == (gen + 1u) * nloc) {
            __builtin_amdgcn_fence(__ATOMIC_RELEASE, "agent");
            asm volatile("s_waitcnt vmcnt(0)" ::: "memory");
            const unsigned og = xb_add(&bar[XB_TOP], 1u);
            const unsigned tg = og / nx;
            if (og + 1u == (tg + 1u) * nx) xb_add(&bar[XB_TOPGEN], 1u);
            else XB_SPIN(xb_ld(&bar[XB_TOPGEN]) == tg, bar);
            __builtin_amdgcn_fence(__ATOMIC_ACQUIRE, "agent");
            xb_add(&bar[XB_XGEN(b.x)], 1u);
            asm volatile("s_waitcnt vmcnt(0)" ::: "memory");
        } else {
            XB_SPIN(xb_ld(&bar[XB_XGEN(b.x)]) == gen, bar);
            __builtin_amdgcn_fence(__ATOMIC_ACQUIRE, "agent");
            asm volatile("s_waitcnt vmcnt(0)" ::: "memory");
        }
    }
    __syncthreads();
}

namespace pg8 {
constexpr int BM = 256, BK = 64, HALF = 128, HTB = HALF * BK * 2, STAGE_BYTES = 8 * HTB, NXCD = 8, WGM = 8;
__host__ __device__ __forceinline__ int lds_byte(int r, int c) { const int st = (r >> 4) * 2 + (c >> 5), rr = r & 15, cc = c & 31, ob = rr * 64 + cc * 2; return st * 1024 + (ob ^ (((ob >> 9) & 1) << 5)); }
__host__ __device__ __forceinline__ void stage_rc(int b, int& R, int& C) { const int st = b / 1024, sb = b % 1024, swz = sb ^ (((sb >> 9) & 1) << 5); R = (st >> 1) * 16 + swz / 64; C = (st & 1) * 32 + (swz % 64) / 2; }
__host__ __device__ __forceinline__ int perm32(int rho) { const int n = rho >> 4, i = rho & 15; return 8 * (i >> 2) + 4 * n + (i & 3); }

struct Unit { int pm, pn, kb; };
struct Gemm { const bf16_t* A; const bf16_t* Bt; int lda, ldb, K; };

template <int NK> struct Order {
    int nM, nN, nwg, G, c;
    __device__ void init(int nM_, int nN_, int G_, int c_) { nM = nM_; nN = nN_; nwg = nM * nN; G = G_; c = c_; }
    __device__ bool next(int i, Unit& u) const {
        const int it = i / NK; u.kb = i - it * NK;
        const long L = (long)it * G + c; if (L >= nwg) return false;
        int wgid = (int)L; { const int q = nwg / NXCD, r = nwg % NXCD, xcd = wgid % NXCD, off = wgid / NXCD; wgid = (xcd < r ? xcd * (q + 1) : r * (q + 1) + (xcd - r) * q) + off; }
        const int nig = WGM * nN, gid = wgid / nig, fm = gid * WGM, gsz = (nM - fm) < WGM ? (nM - fm) : WGM;
        u.pm = fm + ((wgid % nig) % gsz); u.pn = (wgid % nig) / gsz; return true;
    }
};


struct EpiSwiGLU {
    static constexpr bool PERM = true;
    bf16_t* O; const float* ssq;
    __device__ __forceinline__ void operator()(const f32x4 (&acc)[2][2][4][2], const Unit& u, int wr, int wc, int fr, int fq) const {
        const int row0 = u.pm * BM + wr * 64 + fr, col0 = u.pn * HALF + wc * 32 + 8 * fq;
#pragma unroll
        for (int ai = 0; ai < 2; ++ai)
#pragma unroll
            for (int m = 0; m < 4; ++m) {
                const int row = row0 + ai * HALF + m * 16;
                const float rs = rsqrtf(ssq[row] * (1.0f / DM) + EPS);
                float h[8];
#pragma unroll
                for (int n = 0; n < 2; ++n)
#pragma unroll
                    for (int j = 0; j < 4; ++j) { const float g = acc[ai][0][m][n][j] * rs, up = acc[ai][1][m][n][j] * rs; h[n * 4 + j] = siluf_(g) * up; }
                u32x4 w; w.x = cvt_pk_bf16(h[0], h[1]); w.y = cvt_pk_bf16(h[2], h[3]); w.z = cvt_pk_bf16(h[4], h[5]); w.w = cvt_pk_bf16(h[6], h[7]);
                *(u32x4*)(O + (size_t)row * DFF + col0) = w;
            }
    }
};
struct EpiResid {
    static constexpr bool PERM = false;
    float* X; bf16_t* XB; float* ssq_out; float scale;
    __device__ __forceinline__ void operator()(const f32x4 (&acc)[2][2][4][2], const Unit& u, int wr, int wc, int fr, int fq) const {
        const int row0 = u.pm * BM + wr * 64 + fr, col0 = u.pn * BM + wc * 32 + 4 * fq;
#pragma unroll
        for (int ai = 0; ai < 2; ++ai)
#pragma unroll
            for (int m = 0; m < 4; ++m) {
                const int row = row0 + ai * HALF + m * 16; float ss = 0.f;
                float* xp = X + (size_t)row * DM + col0; bf16_t* bp = XB + (size_t)row * DM + col0;
#pragma unroll
                for (int bj = 0; bj < 2; ++bj)
#pragma unroll
                    for (int n = 0; n < 2; ++n) {
                        const f32x4 b = *(const f32x4*)(xp + bj * HALF + n * 16);
                        const f32x4 o = b + acc[ai][bj][m][n] * scale;
                        *(f32x4*)(xp + bj * HALF + n * 16) = o;
                        ss += (o[0] * o[0] + o[1] * o[1]) + (o[2] * o[2] + o[3] * o[3]);
                        u32x2 w; w.x = cvt_pk_bf16(o[0], o[1]); w.y = cvt_pk_bf16(o[2], o[3]);
                        *(u32x2*)(bp + bj * HALF + n * 16) = w;
                    }
                ss += __shfl_xor(ss, 16); ss += __shfl_xor(ss, 32);
                if (fq == 0) atomicAdd(ssq_out + row, ss);
            }
    }
};
struct EpiProj {
    static constexpr bool PERM = true;
    bf16_t* O; const float* ssq;
    __device__ __forceinline__ void operator()(const f32x4 (&acc)[2][2][4][2], const Unit& u, int wr, int wc, int fr, int fq) const {
        const int row0 = u.pm * BM + wr * 64 + fr, col0 = u.pn * BM + wc * 32 + 8 * fq;
#pragma unroll
        for (int ai = 0; ai < 2; ++ai)
#pragma unroll
            for (int m = 0; m < 4; ++m) {
                const int row = row0 + ai * HALF + m * 16;
                const float rs = rsqrtf(ssq[row] * (1.0f / DM) + EPS);
#pragma unroll
                for (int bj = 0; bj < 2; ++bj) { const f32x4 v0 = acc[ai][bj][m][0] * rs, v1 = acc[ai][bj][m][1] * rs;
                    u32x4 w; w.x = cvt_pk_bf16(v0[0], v0[1]); w.y = cvt_pk_bf16(v0[2], v0[3]); w.z = cvt_pk_bf16(v1[0], v1[1]); w.w = cvt_pk_bf16(v1[2], v1[3]);
                    *(u32x4*)(O + (size_t)row * INP + col0 + bj * HALF) = w; }
            }
    }
};
struct EpiBranch {
    static constexpr bool PERM = true;
    const bf16_t* PROJ; float* PART; bf16_t* MRG;
    __device__ __forceinline__ void operator()(const f32x4 (&acc)[2][2][4][2], const Unit& u, int wr, int wc, int fr, int fq) const {
        const int row0 = u.pm * BM + wr * 64 + fr, col0 = u.pn * BM + wc * 32 + 8 * fq;
#pragma unroll
        for (int ai = 0; ai < 2; ++ai)
#pragma unroll
            for (int m = 0; m < 4; ++m) {
                const int row = row0 + ai * HALF + m * 16;
#pragma unroll
                for (int bj = 0; bj < 2; ++bj) {
                    const int col = col0 + bj * HALF;
                    const u32x4 gw = *(const u32x4*)(PROJ + (size_t)row * INP + PC_GATE + u.kb * DM + col);
                    float v[8];
#pragma unroll
                    for (int j = 0; j < 4; ++j) { const unsigned w = gw[j]; const float g0 = sigmoidf_(bf2f(w & 0xffffu)), g1 = sigmoidf_(bf2f(w >> 16));
                        const int e = 2 * j; v[e] = g0 * acc[ai][bj][m][e >> 2][e & 3]; v[e + 1] = g1 * acc[ai][bj][m][(e + 1) >> 2][(e + 1) & 3]; }
                    float* pp = PART + (size_t)row * DM + col;
                    if (u.kb != 0) { const f32x4 p0 = *(const f32x4*)pp, p1 = *(const f32x4*)(pp + 4);
#pragma unroll
                        for (int j = 0; j < 4; ++j) { v[j] += p0[j]; v[4 + j] += p1[j]; } }
                    if (u.kb != 2) { *(f32x4*)pp = (f32x4){v[0], v[1], v[2], v[3]}; *(f32x4*)(pp + 4) = (f32x4){v[4], v[5], v[6], v[7]}; }
                    else { u32x4 w; w.x = cvt_pk_bf16(v[0], v[1]); w.y = cvt_pk_bf16(v[2], v[3]); w.z = cvt_pk_bf16(v[4], v[5]); w.w = cvt_pk_bf16(v[6], v[7]);
                        *(u32x4*)(MRG + (size_t)row * DM + col) = w; }
                }
            }
    }
};

template <class Epi, class Sched>
__device__ __forceinline__ void gemm_phase(LAS unsigned char* lds, const Gemm g, const Sched& S, const Epi& E) {
    int tid = threadIdx.x; asm volatile("" : "+v"(tid));
    const int wid = __builtin_amdgcn_readfirstlane(tid >> 6), lane = tid & 63, wr = wid >> 2, wc = wid & 3, fr = lane & 15, fq = lane >> 4;
    const int K = g.K, nt = K / BK;
    unsigned voffA[2], voffB[2];
#pragma unroll
    for (int i = 0; i < 2; ++i) { int R, C; stage_rc(tid * 16 + i * 8192, R, C); const int Rb = Epi::PERM ? ((R & ~31) + perm32(R & 31)) : R;
        voffA[i] = (unsigned)(R * g.lda + C) * 2u; voffB[i] = (unsigned)(Rb * g.ldb + C) * 2u; }
    const size_t kstep = (size_t)(BK * 2);
    const size_t hstepA = (size_t)HALF * g.lda * 2, hstepB = (size_t)HALF * g.ldb * 2;
    const size_t tstepA = 2 * hstepA, tstepB = 2 * hstepB, kbstep = (size_t)K * 2;
    const unsigned ldsw = (unsigned)wid * 1024u;
    const int aoff = lds_byte(wr * 64 + fr, fq * 8), boff = lds_byte(wc * 32 + fr, fq * 8);
#define PG8_SA(b, h) (((b) * 2 + (h)) * HTB)
#define PG8_SB(b, h) ((4 + (b) * 2 + (h)) * HTB)
#define PG8_STAGE(bufoff, gbase, voff) do { _Pragma("unroll") for (int _i = 0; _i < 2; ++_i) \
        __builtin_amdgcn_global_load_lds((const unsigned*)((const char*)(gbase) + (voff)[_i]), (LAS unsigned*)(lds + (bufoff) + ldsw + _i * 8192), 16, 0, 0); } while (0)
#define PG8_LDA(dst, b, h) do { _Pragma("unroll") for (int m = 0; m < 4; ++m) _Pragma("unroll") for (int k = 0; k < 2; ++k) dst[m][k] = *(const LAS bf16x8*)(lds + PG8_SA(b, h) + aoff + m * 2048 + k * 1024); } while (0)
#define PG8_LDB(dst, b, h) do { _Pragma("unroll") for (int n = 0; n < 2; ++n) _Pragma("unroll") for (int k = 0; k < 2; ++k) dst[n][k] = *(const LAS bf16x8*)(lds + PG8_SB(b, h) + boff + n * 2048 + k * 1024); } while (0)
#define PG8_MMA(ai, bj, At, Bt) do { __builtin_amdgcn_s_setprio(1); _Pragma("unroll") for (int m = 0; m < 4; ++m) _Pragma("unroll") for (int n = 0; n < 2; ++n) _Pragma("unroll") for (int k = 0; k < 2; ++k) \
        acc[ai][bj][m][n] = __builtin_amdgcn_mfma_f32_16x16x32_bf16(Bt[n][k], At[m][k], acc[ai][bj][m][n], 0, 0, 0); __builtin_amdgcn_s_setprio(0); } while (0)
#define PG8_WAIT_V(n) asm volatile("s_waitcnt vmcnt(" #n ")" ::: "memory")
#define PG8_WAIT_L(n) asm volatile("s_waitcnt lgkmcnt(" #n ")" ::: "memory")
#define PG8_BAR __builtin_amdgcn_s_barrier()
#define PG8_SCHED __builtin_amdgcn_sched_barrier(0)
    Unit cur, nxt; int ui = 0;
    if (!S.next(0, cur)) return;
    f32x4 acc[2][2][4][2];
#pragma unroll
    for (int a = 0; a < 2; ++a)
#pragma unroll
        for (int b = 0; b < 2; ++b)
#pragma unroll
            for (int m = 0; m < 4; ++m)
#pragma unroll
                for (int n = 0; n < 2; ++n) acc[a][b][m][n] = (f32x4){0.f, 0.f, 0.f, 0.f};
    bf16x8 At[4][2], B0[2][2], B1[2][2];
    const char* cA = (const char*)g.A + (size_t)cur.pm * tstepA + (size_t)cur.kb * kbstep; const char* cB = (const char*)g.Bt + (size_t)cur.pn * tstepB + (size_t)cur.kb * kbstep;
    PG8_STAGE(PG8_SB(0, 0), cB, voffB); PG8_STAGE(PG8_SB(0, 1), cB + hstepB, voffB); PG8_STAGE(PG8_SA(0, 0), cA, voffA); PG8_STAGE(PG8_SA(0, 1), cA + hstepA, voffA);
    if (wr == 1) PG8_BAR;
    PG8_WAIT_V(2); PG8_BAR;
    PG8_STAGE(PG8_SB(1, 0), cB + kstep, voffB); PG8_STAGE(PG8_SA(1, 0), cA + kstep, voffA); PG8_STAGE(PG8_SB(1, 1), cB + hstepB + kstep, voffB);
    PG8_WAIT_V(6); PG8_BAR;
    for (;;) {
        const bool has_next = S.next(ui + 1, nxt);
        const char* nA = has_next ? (const char*)g.A + (size_t)nxt.pm * tstepA + (size_t)nxt.kb * kbstep : cA;
        const char* nB = has_next ? (const char*)g.Bt + (size_t)nxt.pn * tstepB + (size_t)nxt.kb * kbstep : cB;
        for (int t = 0; t < nt; t += 2) {
            const bool last = (t == nt - 2);
            const char* a1 = cA + (size_t)(t + 1) * kstep;
            const char* a2 = last ? nA : cA + (size_t)(t + 2) * kstep; const char* b2 = last ? nB : cB + (size_t)(t + 2) * kstep;
            const char* a3 = a2 + kstep; const char* b3 = b2 + kstep;
            PG8_LDB(B0, 0, 0); PG8_LDB(B1, 0, 1); PG8_SCHED; PG8_LDA(At, 0, 0); PG8_STAGE(PG8_SA(1, 1), a1 + hstepA, voffA);
            PG8_WAIT_V(8); PG8_WAIT_L(0); PG8_BAR; PG8_MMA(0, 0, At, B0); PG8_MMA(0, 1, At, B1); PG8_BAR; PG8_SCHED;
            PG8_LDA(At, 0, 1); PG8_STAGE(PG8_SB(0, 0), b2, voffB); PG8_STAGE(PG8_SB(0, 1), b2 + hstepB, voffB); PG8_STAGE(PG8_SA(0, 0), a2, voffA);
            PG8_WAIT_V(8); PG8_WAIT_L(0); PG8_BAR; PG8_MMA(1, 0, At, B0); PG8_MMA(1, 1, At, B1); PG8_BAR; PG8_SCHED;
            PG8_LDB(B0, 1, 0); PG8_LDB(B1, 1, 1); PG8_SCHED; PG8_LDA(At, 1, 0); PG8_STAGE(PG8_SA(0, 1), a2 + hstepA, voffA);
            PG8_WAIT_V(8); PG8_WAIT_L(0); PG8_BAR; PG8_MMA(0, 0, At, B0); PG8_MMA(0, 1, At, B1); PG8_BAR; PG8_SCHED;
            PG8_LDA(At, 1, 1); PG8_STAGE(PG8_SB(1, 0), b3, voffB); PG8_STAGE(PG8_SB(1, 1), b3 + hstepB, voffB); PG8_STAGE(PG8_SA(1, 0), a3, voffA);
            PG8_WAIT_V(8); PG8_WAIT_L(0); PG8_BAR; PG8_MMA(1, 0, At, B0); PG8_MMA(1, 1, At, B1); PG8_BAR; PG8_SCHED;
        }
        if (wr == 0) PG8_BAR;
        E(acc, cur, wr, wc, fr, fq);
        if (!has_next) break;
#pragma unroll
        for (int a = 0; a < 2; ++a)
#pragma unroll
            for (int b = 0; b < 2; ++b)
#pragma unroll
                for (int m = 0; m < 4; ++m)
#pragma unroll
                    for (int n = 0; n < 2; ++n) acc[a][b][m][n] = (f32x4){0.f, 0.f, 0.f, 0.f};
        cur = nxt; cA = nA; cB = nB; ++ui;
        if (wr == 1) PG8_BAR;
    }
    PG8_WAIT_V(0);
    PG8_BAR;
#undef PG8_SA
#undef PG8_SB
#undef PG8_STAGE
#undef PG8_LDA
#undef PG8_LDB
#undef PG8_MMA
#undef PG8_WAIT_V
#undef PG8_WAIT_L
#undef PG8_BAR
#undef PG8_SCHED
}
}

struct Args { const float* in[30]; float* out; unsigned char* ws; int ph_lo, ph_hi; };
enum { I_XP = 0, I_XS, I_SCONV, I_SSSM, I_SHGRN, I_SGLA, I_F1N, I_F1GU, I_F1D, I_MIXN, I_WIN, I_CONVW, I_CONVB, I_DTB, I_ALOG, I_DSKIP, I_MNORM, I_LBL, I_HNORM, I_GWD, I_GBD, I_GNORM,
       I_WBM, I_WBH, I_WBG, I_WOUT, I_F2N, I_F2GU, I_F2D, I_FINN };

__device__ __forceinline__ int map_col(int map, int np) {
    if (map == 0) return np;
    if (map == 1) { const int pn = np >> 8, w = np & 255; return w < 128 ? 128 * pn + w : DFF + 128 * pn + (w - 128); }
    if (np < 2560) return np;
    if (np < PC_GATE) return np + 16;
    if (np < PC_DT) return np + 32;
    if (np < PC_GA) return 2560 + (np - PC_DT);
    if (np < INC) return 9744 + (np - PC_GA);
    return -1;
}
__device__ __forceinline__ void transpose_item(const float* W, int N, const float* kscale, bf16_t* WT, int ldk, int koff, int map, int nblk, LAS float* scr, int item, int lane) {
    const int kb = item / nblk, nb = item % nblk, k0 = 64 * kb, n0 = 32 * nb;
    const int src = map_col(map, n0 + (lane & 31));
#pragma unroll 8
    for (int i = 0; i < 32; ++i) { const int kk = 2 * i + (lane >> 5); float v = 0.f; if (src >= 0) v = W[(size_t)(k0 + kk) * N + src]; if (kscale) v *= kscale[k0 + kk]; scr[kk * 33 + (lane & 31)] = v; }
    LDS_WAIT(); asm volatile("" ::: "memory");
    const int c = lane & 7;
#pragma unroll
    for (int j = 0; j < 4; ++j) { const int n = (lane >> 3) + 8 * j; const LAS float* s = scr + (8 * c) * 33 + n;
        u32x4 o; o.x = pk2(s[0 * 33], s[1 * 33]); o.y = pk2(s[2 * 33], s[3 * 33]); o.z = pk2(s[4 * 33], s[5 * 33]); o.w = pk2(s[6 * 33], s[7 * 33]);
        *(u32x4*)(WT + (size_t)(n0 + n) * ldk + koff + k0 + 8 * c) = o; }
    LDS_WAIT(); asm volatile("" ::: "memory");
}

struct Ctx {
    LAS unsigned char* lds; const Args* a; unsigned char* ws; int tid, lane, wave, G, gw, NGW;
};

__device__ __forceinline__ void phase_prologue(const Args& a, LAS unsigned char* lds) {
    int tid = threadIdx.x; asm volatile("" : "+v"(tid));
    const int lane = tid & 63, wave = __builtin_amdgcn_readfirstlane(tid >> 6), gw = blockIdx.x * 8 + wave, NGW = gridDim.x * 8;
    unsigned char* ws = a.ws;
    LAS float* scr = (LAS float*)(lds + wave * 16384);
    constexpr int IT_GU = 32 * 352, IT_D = 88 * 64, IT_IN = 32 * 504, IT_B = 16 * 64, IT_O = 32 * 64;
    constexpr int IT_LAYER = 2 * IT_GU + 2 * IT_D + IT_IN + 3 * IT_B + IT_O;
    for (int it = gw; it < DEPTH * IT_LAYER; it += NGW) {
        const int l = it / IT_LAYER; int r = it - l * IT_LAYER;
        unsigned char* wl = ws + WS_W + (size_t)l * WL_STRIDE;
        if (r < IT_GU) { transpose_item(a.in[I_F1GU] + (size_t)l * DM * 2 * DFF, 2 * DFF, a.in[I_F1N] + l * DM, (bf16_t*)(wl + WL_GU1), DM, 0, 1, 352, scr, r, lane); continue; } r -= IT_GU;
        if (r < IT_D) { transpose_item(a.in[I_F1D] + (size_t)l * DFF * DM, DM, nullptr, (bf16_t*)(wl + WL_D1), DFF, 0, 0, 64, scr, r, lane); continue; } r -= IT_D;
        if (r < IT_IN) { transpose_item(a.in[I_WIN] + (size_t)l * DM * INC, INC, a.in[I_MIXN] + l * DM, (bf16_t*)(wl + WL_IN), DM, 0, 2, 504, scr, r, lane); continue; } r -= IT_IN;
        if (r < IT_B) { transpose_item(a.in[I_WBM] + (size_t)l * 1024 * DM, DM, nullptr, (bf16_t*)(wl + WL_BR), 3072, 0, 0, 64, scr, r, lane); continue; } r -= IT_B;
        if (r < IT_B) { transpose_item(a.in[I_WBH] + (size_t)l * 1024 * DM, DM, nullptr, (bf16_t*)(wl + WL_BR), 3072, 1024, 0, 64, scr, r, lane); continue; } r -= IT_B;
        if (r < IT_B) { transpose_item(a.in[I_WBG] + (size_t)l * 1024 * DM, DM, nullptr, (bf16_t*)(wl + WL_BR), 3072, 2048, 0, 64, scr, r, lane); continue; } r -= IT_B;
        if (r < IT_O) { transpose_item(a.in[I_WOUT] + (size_t)l * DM * DM, DM, nullptr, (bf16_t*)(wl + WL_OUT), DM, 0, 0, 64, scr, r, lane); continue; } r -= IT_O;
        if (r < IT_GU) { transpose_item(a.in[I_F2GU] + (size_t)l * DM * 2 * DFF, 2 * DFF, a.in[I_F2N] + l * DM, (bf16_t*)(wl + WL_GU2), DM, 0, 1, 352, scr, r, lane); continue; } r -= IT_GU;
        transpose_item(a.in[I_F2D] + (size_t)l * DFF * DM, DM, nullptr, (bf16_t*)(wl + WL_D2), DFF, 0, 0, 64, scr, r, lane);
    }
    float* X = (float*)(ws + WS_X); bf16_t* XB = (bf16_t*)(ws + WS_XB); float* ssq0 = (float*)(ws + WS_CTL + CTL_SSQ);
    for (int r = gw; r < MP; r += NGW) {
        const float* src = r < NPROMPT ? a.in[I_XP] + (size_t)r * DM : (r < NTOK ? a.in[I_XS] + (size_t)(r - NPROMPT) * DM : nullptr);
        float ss = 0.f;
#pragma unroll
        for (int j = 0; j < 8; ++j) { f32x4 v = (f32x4){0.f, 0.f, 0.f, 0.f}; if (src) v = *(const f32x4*)(src + 4 * lane + 256 * j);
            *(f32x4*)(X + (size_t)r * DM + 4 * lane + 256 * j) = v; ss += (v[0] * v[0] + v[1] * v[1]) + (v[2] * v[2] + v[3] * v[3]);
            u32x2 w; w.x = pk2(v[0], v[1]); w.y = pk2(v[2], v[3]); *(u32x2*)(XB + (size_t)r * DM + 4 * lane + 256 * j) = w; }
        ss = wave_sum(ss); if (lane == 0) ssq0[r] = ss;
        if (r >= NTOK) { bf16_t* y = (bf16_t*)(ws + WS_Y) + (size_t)r * 3072;
#pragma unroll
            for (int j = 0; j < 6; ++j) *(u32x4*)(y + 8 * lane + 512 * j) = (u32x4){0u, 0u, 0u, 0u}; }
    }
    float* LB = (float*)(ws + WS_LB);
    for (int c = gw * 64 + lane; c < 1024; c += NGW * 64) {
        float mx = -1e30f; for (int l = 0; l < DEPTH; ++l) mx = fmaxf(mx, a.in[I_LBL][l * 1024 + c]);
        float den = 0.f; for (int l = 0; l < DEPTH; ++l) den += expf(a.in[I_LBL][l * 1024 + c] - mx);
        float cum = 0.f; const float sm0 = expf(a.in[I_LBL][c] - mx) / den;
        for (int l = 0; l < DEPTH; ++l) { cum += expf(a.in[I_LBL][l * 1024 + c] - mx) / den; LB[l * 1024 + c] = cum - sm0; }
    }
}

__device__ __forceinline__ void unpack8(const u32x4 w, float (&x)[8]) {
#pragma unroll
    for (int j = 0; j < 4; ++j) { x[2 * j] = bf2f(w[j] & 0xffffu); x[2 * j + 1] = bf2f(w[j] >> 16); }
}
__device__ __forceinline__ void phase_prep(const Args& a, int l, LAS unsigned char* lds) {
    int tid = threadIdx.x; asm volatile("" : "+v"(tid));
    const int lane = tid & 63, wave = __builtin_amdgcn_readfirstlane(tid >> 6), gw = blockIdx.x * 8 + wave, NGW = gridDim.x * 8;
    unsigned char* ws = a.ws;
    const bf16_t* PROJ = (const bf16_t*)(ws + WS_PROJ); bf16_t* XC = (bf16_t*)(ws + WS_XC); float* DT = (float*)(ws + WS_DT); float* LGA = (float*)(ws + WS_LGA);
    LAS float* swd = (LAS float*)lds;
    for (int i = tid; i < 16 * 512; i += 512) swd[i] = a.in[I_GWD][(size_t)l * 16 * 512 + i];
    for (int i = tid; i < 512; i += 512) swd[8192 + i] = a.in[I_GBD][l * 512 + i];
    __syncthreads();
    const float* cw = a.in[I_CONVW] + (size_t)l * 4 * 1536; const float* cb = a.in[I_CONVB] + l * 1536;
    for (int r = gw; r < NTOK; r += NGW) {
        const bool samp = r >= NPROMPT; const int t = samp ? 0 : (r & (SEQ - 1)), s = r - NPROMPT, b = r >> 11;
        const bf16_t* prow = PROJ + (size_t)r * INP;
#pragma unroll 1
        for (int i = 0; i < 3; ++i) {
            const int ch = lane * 8 + 512 * i;
            float c[8], x[8];
            { const f32x4 b0 = *(const f32x4*)(cb + ch), b1 = *(const f32x4*)(cb + ch + 4);
#pragma unroll
              for (int j = 0; j < 4; ++j) { c[j] = b0[j]; c[4 + j] = b1[j]; } }
            unpack8(*(const u32x4*)(prow + PC_XBC + ch), x);
            { const f32x4 w0 = *(const f32x4*)(cw + 3 * 1536 + ch), w1 = *(const f32x4*)(cw + 3 * 1536 + ch + 4);
#pragma unroll
              for (int j = 0; j < 4; ++j) { c[j] += w0[j] * x[j]; c[4 + j] += w1[j] * x[4 + j]; } }
            if (samp) { float* op = a.out + O_CS + (((size_t)l * NSAMP + s) * 3 + 2) * 1536 + ch; *(f32x4*)op = (f32x4){x[0], x[1], x[2], x[3]}; *(f32x4*)(op + 4) = (f32x4){x[4], x[5], x[6], x[7]}; }
            else if (t >= SEQ - 3) { float* op = a.out + O_CP + (((size_t)l * NB + b) * 3 + (t - (SEQ - 3))) * 1536 + ch; *(f32x4*)op = (f32x4){x[0], x[1], x[2], x[3]}; *(f32x4*)(op + 4) = (f32x4){x[4], x[5], x[6], x[7]}; }
#pragma unroll
            for (int k = 1; k <= 3; ++k) {
                if (samp) { const float* sp = a.in[I_SCONV] + (((size_t)l * NSAMP + s) * 3 + (3 - k)) * 1536 + ch; const f32x4 p0 = *(const f32x4*)sp, p1 = *(const f32x4*)(sp + 4);
#pragma unroll
                    for (int j = 0; j < 4; ++j) { x[j] = p0[j]; x[4 + j] = p1[j]; }
                    if (k <= 2) { float* op = a.out + O_CS + (((size_t)l * NSAMP + s) * 3 + (2 - k)) * 1536 + ch; *(f32x4*)op = p0; *(f32x4*)(op + 4) = p1; } }
                else if (t - k >= 0) unpack8(*(const u32x4*)(prow - (size_t)k * INP + PC_XBC + ch), x);
                else {
#pragma unroll
                    for (int j = 0; j < 8; ++j) x[j] = 0.f; }
                const f32x4 w0 = *(const f32x4*)(cw + (3 - k) * 1536 + ch), w1 = *(const f32x4*)(cw + (3 - k) * 1536 + ch + 4);
#pragma unroll
                for (int j = 0; j < 4; ++j) { c[j] += w0[j] * x[j]; c[4 + j] += w1[j] * x[4 + j]; }
            }
            u32x4 w; w.x = pk2(siluf_(c[0]), siluf_(c[1])); w.y = pk2(siluf_(c[2]), siluf_(c[3])); w.z = pk2(siluf_(c[4]), siluf_(c[5])); w.w = pk2(siluf_(c[6]), siluf_(c[7]));
            *(u32x4*)(XC + (size_t)r * 1536 + ch) = w;
        }
        if (lane < 16) DT[(size_t)r * 16 + lane] = softplusf_(bf2f(prow[PC_DT + lane]) + a.in[I_DTB][l * 16 + lane]);
        { float ga[16];
          unpack8(*(const u32x4*)(prow + PC_GA), *(float(*)[8])&ga[0]); unpack8(*(const u32x4*)(prow + PC_GA + 8), *(float(*)[8])&ga[8]);
          float pre[8];
#pragma unroll
          for (int e = 0; e < 8; ++e) pre[e] = swd[8192 + lane * 8 + e];
#pragma unroll
          for (int i = 0; i < 16; ++i)
#pragma unroll
              for (int e = 0; e < 8; ++e) pre[e] += ga[i] * swd[i * 512 + lane * 8 + e];
          float lo[8];
#pragma unroll
          for (int e = 0; e < 8; ++e) lo[e] = -(fmaxf(-pre[e], 0.f) + log1pf(__expf(-fabsf(pre[e])))) * (1.0f / 16.0f);
          float* op = LGA + (size_t)r * 512 + lane * 8;
          *(f32x4*)op = (f32x4){lo[0], lo[1], lo[2], lo[3]}; *(f32x4*)(op + 4) = (f32x4){lo[4], lo[5], lo[6], lo[7]}; }
    }
}

constexpr int TCH = 16;
struct ScanUnit { int mix, seq, h, j0, L, row0; bool samp; };
__device__ __forceinline__ void scan_unit(const Args& a, int l, const ScanUnit& U, LAS unsigned char* lds, const int tid, const int lane, const int wave) {
    unsigned char* ws = a.ws;
    const bf16_t* PROJ = (const bf16_t*)(ws + WS_PROJ); const bf16_t* XC = (const bf16_t*)(ws + WS_XC); const float* DT = (const float*)(ws + WS_DT); const float* LGA = (const float*)(ws + WS_LGA);
    float* O = (float*)(ws + WS_O); const float* LB = (const float*)(ws + WS_LB) + l * 1024;
    LAS float* sq = (LAS float*)lds;
    LAS float* sk = sq + 2 * TCH * 128;
    LAS float* sd = sk + 2 * TCH * 128;
    LAS float* sv = sd + 2 * TCH * 128;
    LAS float* sx = sv + 2 * TCH * 64;
    LAS float* red = sx + 2 * TCH * 64;
    const int mix = U.mix, h = U.h, j0 = U.j0;
    const int d = tid & 127;
    float cA = 0.f, cB = 0.f;
    if (mix == 0) cA = -__expf(a.in[I_ALOG][l * 16 + h]);
    if (mix == 1) cA = LB[h * 128 + d];
    const float dskip = (mix == 0) ? a.in[I_DSKIP][l * 16 + h] : 0.f;
    (void)cB;
    float S[16];
    size_t sbase; int sstride_dk, sstride_dv;
    const float* sin = nullptr; float* sout;
    if (mix == 0) { sstride_dk = 1; sstride_dv = 128;
        if (U.samp) { sbase = (((size_t)l * NSAMP + U.seq) * 16 + h) * 8192; sin = a.in[I_SSSM] + sbase; sout = a.out + O_SS + sbase; }
        else { sbase = (((size_t)l * NB + U.seq) * 16 + h) * 8192; sout = a.out + O_SP + sbase; } }
    else if (mix == 1) { sstride_dk = 128; sstride_dv = 1;
        if (U.samp) { sbase = (((size_t)l * NSAMP + U.seq) * 8 + h) * 16384; sin = a.in[I_SHGRN] + sbase; sout = a.out + O_HS + sbase; }
        else { sbase = (((size_t)l * NB + U.seq) * 8 + h) * 16384; sout = a.out + O_HP + sbase; } }
    else { sstride_dk = 256; sstride_dv = 1;
        if (U.samp) { sbase = (((size_t)l * NSAMP + U.seq) * 4 + h) * 32768; sin = a.in[I_SGLA] + sbase; sout = a.out + O_GS + sbase; }
        else { sbase = (((size_t)l * NB + U.seq) * 4 + h) * 32768; sout = a.out + O_GP + sbase; } }
    const size_t soff = (size_t)(wave * 16) * sstride_dk + (size_t)(j0 + lane) * sstride_dv;
#pragma unroll
    for (int i = 0; i < 16; ++i) S[i] = sin ? sin[soff + (size_t)i * sstride_dk] : 0.f;

    const int nch = (U.L + TCH - 1) / TCH;
    unsigned r0[4], r1[4]; float rx[4]; unsigned rv[2]; float rdt[2];
#define LOAD_RAW(c) do { \
    _Pragma("unroll") \
        for (int ii = 0; ii < 4; ++ii) { const int tk = (tid >> 7) + 4 * ii, t = (c) * TCH + tk; r0[ii] = 0; r1[ii] = 0; rx[ii] = 0.f; \
            if (t < U.L) { const size_t r = (size_t)U.row0 + t; \
                if (mix == 0) { const int grp = h >> 3; r0[ii] = XC[r * 1536 + 1280 + grp * 128 + d]; r1[ii] = XC[r * 1536 + 1024 + grp * 128 + d]; rx[ii] = DT[r * 16 + h]; } \
                else if (mix == 1) { r0[ii] = PROJ[r * INP + PC_HQ + h * 128 + d]; r1[ii] = PROJ[r * INP + PC_HF + h * 128 + d]; } \
                else { r0[ii] = PROJ[r * INP + PC_GQ + h * 128 + d]; r1[ii] = PROJ[r * INP + PC_GK + h * 128 + d]; rx[ii] = LGA[r * 512 + h * 128 + d]; } } } \
    _Pragma("unroll") \
        for (int ii = 0; ii < 2; ++ii) { const int tk = wave + 8 * ii, t = (c) * TCH + tk; rv[ii] = 0; rdt[ii] = 0.f; \
            if (t < U.L) { const size_t r = (size_t)U.row0 + t; \
                if (mix == 0) { rv[ii] = XC[r * 1536 + h * 64 + lane]; rdt[ii] = DT[r * 16 + h]; } \
                else if (mix == 1) rv[ii] = PROJ[r * INP + PC_HI + h * 128 + j0 + lane]; \
                else rv[ii] = PROJ[r * INP + PC_GV + h * 256 + j0 + lane]; } } \
} while (0)
#define STORE_LDS(p) do { \
    _Pragma("unroll") \
        for (int ii = 0; ii < 4; ++ii) { const int tk = (tid >> 7) + 4 * ii; const int o = ((p) * TCH + tk) * 128 + d; const float v0 = bf2f(r0[ii]), v1 = bf2f(r1[ii]); \
            if (mix == 0) { sq[o] = v0; sk[o] = v1; sd[o] = __expf(rx[ii] * cA); } \
            else if (mix == 1) { sq[o] = siluf_(v0) * 0.08838834764831845f; const float sg = sigmoidf_(v1); sd[o] = cA + (1.f - cA) * sg; sk[o] = (1.f - cA) * fast_rcp(1.f + __expf(v1)); } \
            else { sq[o] = v0 * 0.08838834764831845f; sk[o] = v1; sd[o] = __expf(rx[ii]); } } \
    _Pragma("unroll") \
        for (int ii = 0; ii < 2; ++ii) { const int tk = wave + 8 * ii; const int o = ((p) * TCH + tk) * 64 + lane; const float v = bf2f(rv[ii]); \
            if (mix == 0) { sv[o] = v * rdt[ii]; sx[o] = v; } else { sv[o] = v; sx[o] = 0.f; } } \
} while (0)
    __syncthreads();
    LOAD_RAW(0); STORE_LDS(0);
    __syncthreads();
    for (int c = 0; c < nch; ++c) {
        const int p = c & 1; const int ntok = min(TCH, U.L - c * TCH);
        if (c + 1 < nch) LOAD_RAW(c + 1);
        for (int tk = 0; tk < ntok; ++tk) {
            const float v = sv[(p * TCH + tk) * 64 + lane]; float accv = 0.f;
            const LAS f32x4* q4 = (const LAS f32x4*)(sq + (p * TCH + tk) * 128 + wave * 16);
            const LAS f32x4* k4 = (const LAS f32x4*)(sk + (p * TCH + tk) * 128 + wave * 16);
            const LAS f32x4* d4 = (const LAS f32x4*)(sd + (p * TCH + tk) * 128 + wave * 16);
#pragma unroll
            for (int i4 = 0; i4 < 4; ++i4) { const f32x4 qq = q4[i4], kk = k4[i4], dd = d4[i4];
#pragma unroll
                for (int e = 0; e < 4; ++e) { S[i4 * 4 + e] = dd[e] * S[i4 * 4 + e] + kk[e] * v; accv += qq[e] * S[i4 * 4 + e]; } }
            red[(tk * 8 + wave) * 64 + lane] = accv;
        }
        __syncthreads();
#pragma unroll
        for (int ii = 0; ii < 2; ++ii) { const int tk = wave + 8 * ii;
            if (tk < ntok) { float o = 0.f;
#pragma unroll
                for (int gq = 0; gq < 8; ++gq) o += red[(tk * 8 + gq) * 64 + lane];
                o += dskip * sx[(p * TCH + tk) * 64 + lane];
                const size_t r = (size_t)U.row0 + c * TCH + tk;
                const int col = mix == 0 ? h * 64 + lane : (mix == 1 ? 1024 + h * 128 + j0 + lane : 2048 + h * 256 + j0 + lane);
                O[r * 3072 + col] = o; } }
        if (c + 1 < nch) STORE_LDS(p ^ 1);
        __syncthreads();
    }
#pragma unroll
    for (int i = 0; i < 16; ++i) sout[soff + (size_t)i * sstride_dk] = S[i];
}
#undef LOAD_RAW
#undef STORE_LDS
__device__ __forceinline__ void phase_scan(const Args& a, int l, LAS unsigned char* lds) {
    int tid = threadIdx.x; asm volatile("" : "+v"(tid));
    const int lane = tid & 63, wave = __builtin_amdgcn_readfirstlane(tid >> 6), G = gridDim.x;
    const int w = blockIdx.x;
    constexpr int NPU = 192, NSU = 6144;
    const int nsw = G - NPU > 0 ? G - NPU : G;
    if (w < NPU) { const int mix = w / 64, rem = w % 64, b = rem / 16, hs = rem % 16; ScanUnit U; U.mix = mix; U.seq = b; U.samp = false; U.L = SEQ; U.row0 = b * SEQ;
        if (mix == 0) { U.h = hs; U.j0 = 0; } else if (mix == 1) { U.h = hs >> 1; U.j0 = 64 * (hs & 1); } else { U.h = hs >> 2; U.j0 = 64 * (hs & 3); }
        scan_unit(a, l, U, lds, tid, lane, wave); }
    const int sw = (G > NPU) ? w - NPU : w;
    if (sw >= 0) for (int su = sw; su < NSU; su += nsw) { const int mix = su / 2048, rem = su % 2048, s = rem / 16, hs = rem % 16; ScanUnit U; U.mix = mix; U.seq = s; U.samp = true; U.L = 1; U.row0 = NPROMPT + s;
        if (mix == 0) { U.h = hs; U.j0 = 0; } else if (mix == 1) { U.h = hs >> 1; U.j0 = 64 * (hs & 1); } else { U.h = hs >> 2; U.j0 = 64 * (hs & 3); }
        scan_unit(a, l, U, lds, tid, lane, wave); }
}

__device__ __forceinline__ void phase_post(const Args& a, int l) {
    int tid = threadIdx.x; asm volatile("" : "+v"(tid));
    const int lane = tid & 63, wave = __builtin_amdgcn_readfirstlane(tid >> 6), gw = blockIdx.x * 8 + wave, NGW = gridDim.x * 8;
    unsigned char* ws = a.ws;
    const bf16_t* PROJ = (const bf16_t*)(ws + WS_PROJ); const float* O = (const float*)(ws + WS_O); bf16_t* Y = (bf16_t*)(ws + WS_Y);
    const float* mnw = a.in[I_MNORM] + l * 1024; const float* hnw = a.in[I_HNORM] + l * 128; const float* gnw = a.in[I_GNORM] + l * 256;
    for (int r = gw; r < NTOK; r += NGW) {
        const float* orow = O + (size_t)r * 3072; const bf16_t* prow = PROJ + (size_t)r * INP; bf16_t* yrow = Y + (size_t)r * 3072;
#pragma unroll
        for (int g = 0; g < 2; ++g) { const int c0 = g * 512 + lane * 8; float y[8]; float ss = 0.f;
            const f32x4 o0 = *(const f32x4*)(orow + c0), o1 = *(const f32x4*)(orow + c0 + 4); const u32x4 zw = *(const u32x4*)(prow + PC_Z + c0);
#pragma unroll
            for (int j = 0; j < 4; ++j) { y[2 * j] = (j < 2 ? o0[2 * j] : o1[2 * j - 4]) * siluf_(bf2f(zw[j] & 0xffffu)); y[2 * j + 1] = (j < 2 ? o0[2 * j + 1] : o1[2 * j - 3]) * siluf_(bf2f(zw[j] >> 16)); }
#pragma unroll
            for (int j = 0; j < 8; ++j) ss += y[j] * y[j];
            ss = wave_sum(ss); const float rs = rsqrtf(ss * (1.0f / 512.0f) + EPS);
            u32x4 w; w.x = pk2(y[0] * rs * mnw[c0], y[1] * rs * mnw[c0 + 1]); w.y = pk2(y[2] * rs * mnw[c0 + 2], y[3] * rs * mnw[c0 + 3]); w.z = pk2(y[4] * rs * mnw[c0 + 4], y[5] * rs * mnw[c0 + 5]); w.w = pk2(y[6] * rs * mnw[c0 + 6], y[7] * rs * mnw[c0 + 7]);
            *(u32x4*)(yrow + c0) = w; }
#pragma unroll
        for (int hh = 0; hh < 8; ++hh) { const int c0 = hh * 128 + lane * 2; const f32x2 o = *(const f32x2*)(orow + 1024 + c0); const unsigned gwv = *(const unsigned*)(prow + PC_HG + c0);
            float ss = wave_sum(o[0] * o[0] + o[1] * o[1]); const float rs = rsqrtf(ss * (1.0f / 128.0f) + EPS);
            *(unsigned*)(yrow + 1024 + c0) = pk2(o[0] * rs * hnw[lane * 2] * siluf_(bf2f(gwv & 0xffffu)), o[1] * rs * hnw[lane * 2 + 1] * siluf_(bf2f(gwv >> 16))); }
#pragma unroll
        for (int hh = 0; hh < 4; ++hh) { const int c0 = hh * 256 + lane * 4; const f32x4 o = *(const f32x4*)(orow + 2048 + c0); const u32x2 gwv = *(const u32x2*)(prow + PC_GG + c0);
            float ss = wave_sum((o[0] * o[0] + o[1] * o[1]) + (o[2] * o[2] + o[3] * o[3])); const float rs = rsqrtf(ss * (1.0f / 256.0f) + EPS);
            u32x2 w; w.x = pk2(o[0] * rs * gnw[lane * 4] * siluf_(bf2f(gwv.x & 0xffffu)), o[1] * rs * gnw[lane * 4 + 1] * siluf_(bf2f(gwv.x >> 16)));
            w.y = pk2(o[2] * rs * gnw[lane * 4 + 2] * siluf_(bf2f(gwv.y & 0xffffu)), o[3] * rs * gnw[lane * 4 + 3] * siluf_(bf2f(gwv.y >> 16)));
            *(u32x2*)(yrow + 2048 + c0) = w; }
    }
}

__device__ __forceinline__ void phase_final(const Args& a) {
    int tid = threadIdx.x; asm volatile("" : "+v"(tid));
    const int lane = tid & 63, wave = __builtin_amdgcn_readfirstlane(tid >> 6), gw = blockIdx.x * 8 + wave, NGW = gridDim.x * 8;
    const float* X = (const float*)(a.ws + WS_X); const float* ssq = (const float*)(a.ws + WS_CTL + CTL_SSQ) + (size_t)(3 * DEPTH) * MP; const float* fw = a.in[I_FINN];
    for (int r = gw; r < NTOK; r += NGW) {
        const float rs = rsqrtf(ssq[r] * (1.0f / DM) + EPS);
        float* o = r < NPROMPT ? a.out + O_YP + (size_t)r * DM : a.out + O_YS + (size_t)(r - NPROMPT) * DM;
#pragma unroll
        for (int j = 0; j < 8; ++j) { const f32x4 v = *(const f32x4*)(X + (size_t)r * DM + 4 * lane + 256 * j), w = *(const f32x4*)(fw + 4 * lane + 256 * j);
            *(f32x4*)(o + 4 * lane + 256 * j) = v * rs * w; }
    }
}

__global__ void __launch_bounds__(512, 2) fwd(Args args) {
    extern __shared__ __attribute__((aligned(16))) unsigned char lds_raw[];
    LAS unsigned char* lds = (LAS unsigned char*)lds_raw;
    volatile LAS unsigned* MISC = (volatile LAS unsigned*)(lds + MISC_OFF);
    const int G = gridDim.x;
    unsigned char* ws = args.ws;
    unsigned* ctl = (unsigned*)(ws + WS_CTL);
    for (int u = threadIdx.x; u < (LDS_BYTES - 131072) / 4; u += 512) ((LAS unsigned*)(lds + 131072))[u] = 0u;
    __syncthreads();
    XcdBarrier bar; bar.bar = ctl + CW_BAR; bar.x = 0; bar.st = nullptr;
    const int lo = args.ph_lo, hi = args.ph_hi;
    const bool multi = (hi - lo) > 1;
    if (multi) bar = xcd_barrier_post(ctl + CW_BAR, MISC + 8);
#define IN(k) (lo <= (k) && (k) < hi)
#define SEAM(k) do { if (IN(k) && IN((k) + 1)) xcd_barrier(bar); } while (0)
    float* ssq = (float*)(ws + WS_CTL + CTL_SSQ);
    float* X = (float*)(ws + WS_X); bf16_t* XB = (bf16_t*)(ws + WS_XB); bf16_t* ACT = (bf16_t*)(ws + WS_ACT); bf16_t* PROJ = (bf16_t*)(ws + WS_PROJ);
    bf16_t* Y = (bf16_t*)(ws + WS_Y); float* PART = (float*)(ws + WS_PART); bf16_t* MRG = (bf16_t*)(ws + WS_MRG);
    int ph = 0;
    if (PHON(0) && IN(ph)) { phase_prologue(args, lds); } SEAM(ph); ++ph;
    for (int it = 0; it < 3 * DEPTH; ++it) {
        const int l = it / 3, kind = it - 3 * l;
        unsigned char* wl = ws + WS_W + (size_t)l * WL_STRIDE;
        if (kind != 1) {
            const int si = 3 * l + (kind == 0 ? 0 : 2);
            if (PHON(1) && IN(ph)) { pg8::Gemm g{XB, (const bf16_t*)(wl + (kind == 0 ? WL_GU1 : WL_GU2)), DM, DM, DM}; pg8::Order<1> S; S.init(MP / 256, 2 * DFF / 256, G, (int)blockIdx.x);
                pg8::EpiSwiGLU E{ACT, ssq + (size_t)si * MP}; pg8::gemm_phase(lds, g, S, E); } SEAM(ph); ++ph;
            if (PHON(2) && IN(ph)) { pg8::Gemm g{ACT, (const bf16_t*)(wl + (kind == 0 ? WL_D1 : WL_D2)), DFF, DFF, DFF}; pg8::Order<1> S; S.init(MP / 256, DM / 256, G, (int)blockIdx.x);
                pg8::EpiResid E{X, XB, ssq + (size_t)(si + 1) * MP, 0.5f}; pg8::gemm_phase(lds, g, S, E); } SEAM(ph); ++ph;
        } else {
            if (PHON(3) && IN(ph)) { pg8::Gemm g{XB, (const bf16_t*)(wl + WL_IN), DM, DM, DM}; pg8::Order<1> S; S.init(MP / 256, INP / 256, G, (int)blockIdx.x);
                pg8::EpiProj E{PROJ, ssq + (size_t)(3 * l + 1) * MP}; pg8::gemm_phase(lds, g, S, E); } SEAM(ph); ++ph;
            if (PHON(4) && IN(ph)) { phase_prep(args, l, lds); } SEAM(ph); ++ph;
            if (PHON(5) && IN(ph)) { phase_scan(args, l, lds); } SEAM(ph); ++ph;
            if (PHON(6) && IN(ph)) { phase_post(args, l); } SEAM(ph); ++ph;
            if (PHON(7) && IN(ph)) { pg8::Gemm g{Y, (const bf16_t*)(wl + WL_BR), 3072, 3072, 1024}; pg8::Order<3> S; S.init(MP / 256, DM / 256, G, (int)blockIdx.x);
                pg8::EpiBranch E{PROJ, PART, MRG}; pg8::gemm_phase(lds, g, S, E); } SEAM(ph); ++ph;
            if (PHON(8) && IN(ph)) { pg8::Gemm g{MRG, (const bf16_t*)(wl + WL_OUT), DM, DM, DM}; pg8::Order<1> S; S.init(MP / 256, DM / 256, G, (int)blockIdx.x);
                pg8::EpiResid E{X, XB, ssq + (size_t)(3 * l + 2) * MP, 1.0f}; pg8::gemm_phase(lds, g, S, E); } SEAM(ph); ++ph;
        }
    }
    if (PHON(9) && IN(ph)) { phase_final(args); } ++ph;
#undef IN
#undef SEAM
}
constexpr int N_PHASES = 1 + DEPTH * 10 + 1;

extern "C" void kernel_launch(void* const* d_in, const int* in_sizes, int n_in, void* d_out, int out_size, void* d_ws, size_t ws_size, hipStream_t stream) {
    static int grid = 0;
    if (grid == 0) {
        if (n_in != 30 || (size_t)out_size != O_END || ws_size < WS_END) { fprintf(stderr, "kernel_launch: unexpected problem: n_in %d out %d ws %zu (need %zu)\n", n_in, out_size, ws_size, (size_t)WS_END); grid = -1; return; }
        int dev = 0, cus = 0, per_cu = 0;
        if (hipGetDevice(&dev) != hipSuccess || hipDeviceGetAttribute(&cus, hipDeviceAttributeMultiprocessorCount, dev) != hipSuccess) { grid = -1; return; }
        if (hipFuncSetAttribute((const void*)fwd, hipFuncAttributeMaxDynamicSharedMemorySize, LDS_BYTES) != hipSuccess) { fprintf(stderr, "kernel_launch: hipFuncSetAttribute failed\n"); grid = -1; return; }
        if (hipOccupancyMaxActiveBlocksPerMultiprocessor(&per_cu, (const void*)fwd, 512, LDS_BYTES) != hipSuccess || per_cu < 1) fprintf(stderr, "kernel_launch: occupancy query reports %d\n", per_cu);
        (void)hipGetLastError();
        grid = cus;
    }
    if (grid < 0) return;
    (void)hipMemsetAsync((char*)d_ws + WS_CTL, 0, CTL_ZERO_BYTES, stream);
    Args a{};
    for (int i = 0; i < 30; ++i) a.in[i] = (const float*)d_in[i];
    a.out = (float*)d_out; a.ws = (unsigned char*)d_ws;
#if MK_PER_PHASE
    for (int p = 0; p < N_PHASES; ++p) { a.ph_lo = p; a.ph_hi = p + 1; hipLaunchKernelGGL(fwd, dim3(grid), dim3(512), LDS_BYTES, stream, a); }
#else
    a.ph_lo = 0; a.ph_hi = N_PHASES; hipLaunchKernelGGL(fwd, dim3(grid), dim3(512), LDS_BYTES, stream, a);
#endif
}
```

```cpp
#include <hip/hip_runtime.h>
#include <cstdio>
#include <cstdint>

#ifndef PHMASK
#define PHMASK 0xFFFF
#endif
#define PHON(k) ((PHMASK >> (k)) & 1)
#ifndef REP_SITE
#define REP_SITE -1
#endif
#define NREP(k) ((REP_SITE == (k)) ? 2 : 1)
#ifndef MK_PER_PHASE
#define MK_PER_PHASE 0
#endif

#define LAS __attribute__((address_space(3)))
#define GAS __attribute__((address_space(1)))
typedef unsigned short bf16_t;
typedef short bf16x8 __attribute__((ext_vector_type(8)));
typedef float f32x4 __attribute__((ext_vector_type(4)));
typedef float f32x2 __attribute__((ext_vector_type(2)));
typedef unsigned u32x4 __attribute__((ext_vector_type(4)));
typedef unsigned u32x2 __attribute__((ext_vector_type(2)));

constexpr int DM = 2048, DFF = 5632, SEQ = 2048, NB = 4, NPROMPT = NB * SEQ, NSAMP = 128, NTOK = NPROMPT + NSAMP, MP = 8448  , DEPTH = 2;
constexpr int INC = 15904, INP = 16128;
constexpr float EPS = 1e-6f;
constexpr int PC_Z = 0, PC_XBC = 1024, PC_HQ = 2560, PC_HF = 3584, PC_HI = 4608, PC_HG = 5632, PC_GQ = 6656, PC_GK = 7168, PC_GV = 7680, PC_GG = 8704, PC_GATE = 9728, PC_DT = 15872, PC_GA = 15888;
constexpr size_t O_YP = 0, O_YS = 16777216, O_CP = 17039360, O_SP = 17076224, O_HP = 18124800, O_GP = 19173376, O_CS = 20221952, O_SS = 21401600, O_HS = 54956032, O_GS = 88510464, O_END = 122064896;

constexpr size_t MiB = 1u << 20;
constexpr size_t WS_CTL = 0, CTL_ZERO_BYTES = 1 * MiB;
constexpr size_t WS_LB = 1 * MiB, WS_DT = 2 * MiB, WS_LGA = 3 * MiB, WS_XC = 20 * MiB, WS_X = 45 * MiB, WS_XB = 111 * MiB, WS_ACT = 144 * MiB, WS_PROJ = 235 * MiB,
                 WS_O = 495 * MiB, WS_Y = 594 * MiB, WS_PART = 644 * MiB, WS_MRG = 710 * MiB, WS_W = 743 * MiB;
constexpr size_t WL_GU1 = 0, WL_D1 = 44 * MiB, WL_IN = 66 * MiB, WL_BR = 129 * MiB, WL_OUT = 141 * MiB, WL_GU2 = 149 * MiB, WL_D2 = 193 * MiB, WL_STRIDE = 215 * MiB;
constexpr size_t WS_END = WS_W + 2 * WL_STRIDE;
constexpr int CW_BAR = 4096;
constexpr size_t CTL_SSQ = 512 * 1024;
constexpr int LDS_BYTES = 147456;
constexpr int MISC_OFF = 131072 + 320;

__device__ __forceinline__ float bf2f(unsigned b) { return __uint_as_float(b << 16); }
__device__ __forceinline__ unsigned f2bf(float f) { unsigned u = __float_as_uint(f); return (u + 0x7fffu + ((u >> 16) & 1u)) >> 16; }
__device__ __forceinline__ unsigned pk2(float lo, float hi) { return f2bf(lo) | (f2bf(hi) << 16); }
__device__ __forceinline__ unsigned cvt_pk_bf16(float lo, float hi) { unsigned r; asm volatile("v_cvt_pk_bf16_f32 %0, %1, %2" : "=v"(r) : "v"(lo), "v"(hi)); return r; }
__device__ __forceinline__ float fast_rcp(float x) { return __builtin_amdgcn_rcpf(x); }
__device__ __forceinline__ float sigmoidf_(float x) { return fast_rcp(1.0f + __expf(-x)); }
__device__ __forceinline__ float siluf_(float x) { return x * sigmoidf_(x); }
__device__ __forceinline__ float softplusf_(float x) { return x > 20.f ? x : log1pf(__expf(x)); }
__device__ __forceinline__ float wave_sum(float v) {
#pragma unroll
    for (int o = 1; o < 64; o <<= 1) v += __shfl_xor(v, o);
    return v;
}
#define LDS_WAIT() asm volatile("s_waitcnt lgkmcnt(0)" ::: "memory")
#define VM_WAIT() asm volatile("s_waitcnt vmcnt(0)" ::: "memory")

#define XB_TMO      128
#define XB_XCNT(j)  (256  + 64 * (j))
#define XB_XSUB(j)  (1280 + 64 * (j))
#define XB_XGEN(j)  (2304 + 64 * (j))
#define XB_TOP      3328
#define XB_TOPGEN   3392
#define XCD_BAR_WORDS 3456
#define XB_SPIN_CAP (1u << 18)
__device__ __forceinline__ unsigned xb_ld(unsigned* p)              { return __hip_atomic_load(p, __ATOMIC_RELAXED, __HIP_MEMORY_SCOPE_AGENT); }
__device__ __forceinline__ unsigned xb_add(unsigned* p, unsigned v) { return __hip_atomic_fetch_add(p, v, __ATOMIC_RELAXED, __HIP_MEMORY_SCOPE_AGENT); }
__device__ __forceinline__ unsigned xb_xcc_id() { return (unsigned)__builtin_amdgcn_s_getreg((3 << 11) | 20) & 0xFu; }
#define XB_SPIN(cond, bar) do { unsigned _sp = 0; while (cond) { __builtin_amdgcn_s_sleep(1); \
    if ((++_sp & 255u) == 0u) { if (xb_ld(&(bar)[XB_TMO])) break; if (_sp > XB_SPIN_CAP) { atomicAdd(&(bar)[XB_TMO], 1u); break; } } } } while (0)
struct XcdBarrier { unsigned* bar; unsigned x; volatile LAS unsigned* st; };
__device__ __forceinline__ XcdBarrier xcd_barrier_post(unsigned* bar, volatile LAS unsigned* st) {
    XcdBarrier b; b.bar = bar; b.x = xb_xcc_id(); b.st = st;
    if (threadIdx.x == 0) (void)xb_add(&bar[XB_XCNT(b.x)], 1u);
    return b;
}
__device__ __forceinline__ void xcd_barrier_complete(unsigned* bar, unsigned x, unsigned& nloc, unsigned& nx) {
    const unsigned G = gridDim.x * gridDim.y * gridDim.z;
    unsigned sum, cnt, mine, sp = 0u;
    for (;;) {
        sum = 0u; cnt = 0u; mine = 0u;
#pragma unroll
        for (unsigned j = 0; j < 16; ++j) { const unsigned c = xb_ld(&bar[XB_XCNT(j)]); sum += c; cnt += (c > 0u) ? 1u : 0u; mine = (j == x) ? c : mine; }
        if (sum == G) break;
        __builtin_amdgcn_s_sleep(1);
        if ((++sp & 255u) == 0u) { if (xb_ld(&bar[XB_TMO])) break; if (sp > XB_SPIN_CAP) { atomicAdd(&bar[XB_TMO], 1u); break; } }
    }
    nloc = mine > 0u ? mine : 1u; nx = cnt > 0u ? cnt : 1u;
}
__device__ __forceinline__ void xcd_barrier(const XcdBarrier& b) {
    asm volatile("s_waitcnt vmcnt(0)" ::: "memory");
    __syncthreads();
    if (threadIdx.x == 0) {
        unsigned* bar = b.bar;
        __builtin_amdgcn_s_waitcnt(0);
        unsigned nloc = b.st[0], nx = b.st[1];
        if (nloc == 0u) { xcd_barrier_complete(bar, b.x, nloc, nx); b.st[0] = nloc; b.st[1] = nx; }
        const unsigned old = xb_add(&bar[XB_XSUB(b.x)], 1u);
        const unsigned gen = old / nloc;
        if (old + 1u == (gen + 1u) * nloc) {
            __builtin_amdgcn_fence(__ATOMIC_RELEASE, "agent");
            asm volatile("s_waitcnt vmcnt(0)" ::: "memory");
            const unsigned og = xb_add(&bar[XB_TOP], 1u);
            const unsigned tg = og / nx;
            if (og + 1u == (tg + 1u) * nx) xb_add(&bar[XB_TOPGEN], 1u);
            else XB_SPIN(xb_ld(&bar[XB_TOPGEN]) == tg, bar);
            __builtin_amdgcn_fence(__ATOMIC_ACQUIRE, "agent");
            xb_add(&bar[XB_XGEN(b.x)], 1u);
            asm volatile("s_waitcnt vmcnt(0)" ::: "memory");
        } else {
            XB_SPIN(xb_ld(&bar[XB_XGEN(b.x)]) == gen, bar);
            __builtin_amdgcn_fence(__ATOMIC_ACQUIRE, "agent");
            asm volatile("s_waitcnt vmcnt(0)" ::: "memory");
        }
    }
    __syncthreads();
}

namespace pg8 {
constexpr int BM = 256, BK = 64, HALF = 128, HTB = HALF * BK * 2, STAGE_BYTES = 8 * HTB, NXCD = 8, WGM = 8;
__host__ __device__ __forceinline__ int lds_byte(int r, int c) { const int st = (r >> 4) * 2 + (c >> 5), rr = r & 15, cc = c & 31, ob = rr * 64 + cc * 2; return st * 1024 + (ob ^ (((ob >> 9) & 1) << 5)); }
__host__ __device__ __forceinline__ void stage_rc(int b, int& R, int& C) { const int st = b / 1024, sb = b % 1024, swz = sb ^ (((sb >> 9) & 1) << 5); R = (st >> 1) * 16 + swz / 64; C = (st & 1) * 32 + (swz % 64) / 2; }
__host__ __device__ __forceinline__ int perm32(int rho) { const int n = rho >> 4, i = rho & 15; return 8 * (i >> 2) + 4 * n + (i & 3); }

struct Unit { int pm, pn, kb; };
struct Gemm { const bf16_t* A; const bf16_t* Bt; int lda, ldb, K; };

template <int NK> struct Order {
    int nM, nN, nwg, G, c;
    __device__ void init(int nM_, int nN_, int G_, int c_) { nM = nM_; nN = nN_; nwg = nM * nN; G = G_; c = c_; }
    __device__ bool next(int i, Unit& u) const {
        const int it = i / NK; u.kb = i - it * NK;
        const long L = (long)it * G + c; if (L >= nwg) return false;
        int wgid = (int)L; { const int q = nwg / NXCD, r = nwg % NXCD, xcd = wgid % NXCD, off = wgid / NXCD; wgid = (xcd < r ? xcd * (q + 1) : r * (q + 1) + (xcd - r) * q) + off; }
        const int nig = WGM * nN, gid = wgid / nig, fm = gid * WGM, gsz = (nM - fm) < WGM ? (nM - fm) : WGM;
        u.pm = fm + ((wgid % nig) % gsz); u.pn = (wgid % nig) / gsz; return true;
    }
};


struct EpiSwiGLU {
    static constexpr bool PERM = true;
    bf16_t* O; const float* ssq;
    __device__ __forceinline__ void operator()(const f32x4 (&acc)[2][2][4][2], const Unit& u, int wr, int wc, int fr, int fq) const {
        const int row0 = u.pm * BM + wr * 64 + fr, col0 = u.pn * HALF + wc * 32 + 8 * fq;
#pragma unroll
        for (int ai = 0; ai < 2; ++ai)
#pragma unroll
            for (int m = 0; m < 4; ++m) {
                const int row = row0 + ai * HALF + m * 16;
                const float rs = rsqrtf(ssq[row] * (1.0f / DM) + EPS);
                float h[8];
#pragma unroll
                for (int n = 0; n < 2; ++n)
#pragma unroll
                    for (int j = 0; j < 4; ++j) { const float g = acc[ai][0][m][n][j] * rs, up = acc[ai][1][m][n][j] * rs; h[n * 4 + j] = siluf_(g) * up; }
                u32x4 w; w.x = cvt_pk_bf16(h[0], h[1]); w.y = cvt_pk_bf16(h[2], h[3]); w.z = cvt_pk_bf16(h[4], h[5]); w.w = cvt_pk_bf16(h[6], h[7]);
                *(u32x4*)(O + (size_t)row * DFF + col0) = w;
            }
    }
};
struct EpiResid {
    static constexpr bool PERM = false;
    float* X; bf16_t* XB; float* ssq_out; float scale;
    __device__ __forceinline__ void operator()(const f32x4 (&acc)[2][2][4][2], const Unit& u, int wr, int wc, int fr, int fq) const {
        const int row0 = u.pm * BM + wr * 64 + fr, col0 = u.pn * BM + wc * 32 + 4 * fq;
#pragma unroll
        for (int ai = 0; ai < 2; ++ai)
#pragma unroll
            for (int m = 0; m < 4; ++m) {
                const int row = row0 + ai * HALF + m * 16; float ss = 0.f;
                float* xp = X + (size_t)row * DM + col0; bf16_t* bp = XB + (size_t)row * DM + col0;
#pragma unroll
                for (int bj = 0; bj < 2; ++bj)
#pragma unroll
                    for (int n = 0; n < 2; ++n) {
                        const f32x4 b = *(const f32x4*)(xp + bj * HALF + n * 16);
                        const f32x4 o = b + acc[ai][bj][m][n] * scale;
                        *(f32x4*)(xp + bj * HALF + n * 16) = o;
                        ss += (o[0] * o[0] + o[1] * o[1]) + (o[2] * o[2] + o[3] * o[3]);
                        u32x2 w; w.x = cvt_pk_bf16(o[0], o[1]); w.y = cvt_pk_bf16(o[2], o[3]);
                        *(u32x2*)(bp + bj * HALF + n * 16) = w;
                    }
                ss += __shfl_xor(ss, 16); ss += __shfl_xor(ss, 32);
                if (fq == 0) atomicAdd(ssq_out + row, ss);
            }
    }
};
struct EpiProj {
    static constexpr bool PERM = true;
    bf16_t* O; const float* ssq;
    __device__ __forceinline__ void operator()(const f32x4 (&acc)[2][2][4][2], const Unit& u, int wr, int wc, int fr, int fq) const {
        const int row0 = u.pm * BM + wr * 64 + fr, col0 = u.pn * BM + wc * 32 + 8 * fq;
#pragma unroll
        for (int ai = 0; ai < 2; ++ai)
#pragma unroll
            for (int m = 0; m < 4; ++m) {
                const int row = row0 + ai * HALF + m * 16;
                const float rs = rsqrtf(ssq[row] * (1.0f / DM) + EPS);
#pragma unroll
                for (int bj = 0; bj < 2; ++bj) { const f32x4 v0 = acc[ai][bj][m][0] * rs, v1 = acc[ai][bj][m][1] * rs;
                    u32x4 w; w.x = cvt_pk_bf16(v0[0], v0[1]); w.y = cvt_pk_bf16(v0[2], v0[3]); w.z = cvt_pk_bf16(v1[0], v1[1]); w.w = cvt_pk_bf16(v1[2], v1[3]);
                    *(u32x4*)(O + (size_t)row * INP + col0 + bj * HALF) = w; }
            }
    }
};
struct EpiBranch {
    static constexpr bool PERM = true;
    const bf16_t* PROJ; float* PART; bf16_t* MRG;
    __device__ __forceinline__ void operator()(const f32x4 (&acc)[2][2][4][2], const Unit& u, int wr, int wc, int fr, int fq) const {
        const int row0 = u.pm * BM + wr * 64 + fr, col0 = u.pn * BM + wc * 32 + 8 * fq;
#pragma unroll
        for (int ai = 0; ai < 2; ++ai)
#pragma unroll
            for (int m = 0; m < 4; ++m) {
                const int row = row0 + ai * HALF + m * 16;
#pragma unroll
                for (int bj = 0; bj < 2; ++bj) {
                    const int col = col0 + bj * HALF;
                    const u32x4 gw = *(const u32x4*)(PROJ + (size_t)row * INP + PC_GATE + u.kb * DM + col);
                    float v[8];
#pragma unroll
                    for (int j = 0; j < 4; ++j) { const unsigned w = gw[j]; const float g0 = sigmoidf_(bf2f(w & 0xffffu)), g1 = sigmoidf_(bf2f(w >> 16));
                        const int e = 2 * j; v[e] = g0 * acc[ai][bj][m][e >> 2][e & 3]; v[e + 1] = g1 * acc[ai][bj][m][(e + 1) >> 2][(e + 1) & 3]; }
                    float* pp = PART + (size_t)row * DM + col;
                    if (u.kb != 0) { const f32x4 p0 = *(const f32x4*)pp, p1 = *(const f32x4*)(pp + 4);
#pragma unroll
                        for (int j = 0; j < 4; ++j) { v[j] += p0[j]; v[4 + j] += p1[j]; } }
                    if (u.kb != 2) { *(f32x4*)pp = (f32x4){v[0], v[1], v[2], v[3]}; *(f32x4*)(pp + 4) = (f32x4){v[4], v[5], v[6], v[7]}; }
                    else { u32x4 w; w.x = cvt_pk_bf16(v[0], v[1]); w.y = cvt_pk_bf16(v[2], v[3]); w.z = cvt_pk_bf16(v[4], v[5]); w.w = cvt_pk_bf16(v[6], v[7]);
                        *(u32x4*)(MRG + (size_t)row * DM + col) = w; }
                }
            }
    }
};

template <class Epi, class Sched>
__device__ __forceinline__ void gemm_phase(LAS unsigned char* lds, const Gemm g, const Sched& S, const Epi& E) {
    int tid = threadIdx.x; asm volatile("" : "+v"(tid));
    const int wid = __builtin_amdgcn_readfirstlane(tid >> 6), lane = tid & 63, wr = wid >> 2, wc = wid & 3, fr = lane & 15, fq = lane >> 4;
    const int K = g.K, nt = K / BK;
    unsigned voffA[2], voffB[2];
#pragma unroll
    for (int i = 0; i < 2; ++i) { int R, C; stage_rc(tid * 16 + i * 8192, R, C); const int Rb = Epi::PERM ? ((R & ~31) + perm32(R & 31)) : R;
        voffA[i] = (unsigned)(R * g.lda + C) * 2u; voffB[i] = (unsigned)(Rb * g.ldb + C) * 2u; }
    const size_t kstep = (size_t)(BK * 2);
    const size_t hstepA = (size_t)HALF * g.lda * 2, hstepB = (size_t)HALF * g.ldb * 2;
    const size_t tstepA = 2 * hstepA, tstepB = 2 * hstepB, kbstep = (size_t)K * 2;
    const unsigned ldsw = (unsigned)wid * 1024u;
    const int aoff = lds_byte(wr * 64 + fr, fq * 8), boff = lds_byte(wc * 32 + fr, fq * 8);
#define PG8_SA(b, h) (((b) * 2 + (h)) * HTB)
#define PG8_SB(b, h) ((4 + (b) * 2 + (h)) * HTB)
#define PG8_STAGE(bufoff, gbase, voff) do { _Pragma("unroll") for (int _i = 0; _i < 2; ++_i) \
        __builtin_amdgcn_global_load_lds((const unsigned*)((const char*)(gbase) + (voff)[_i]), (LAS unsigned*)(lds + (bufoff) + ldsw + _i * 8192), 16, 0, 0); } while (0)
#define PG8_LDA(dst, b, h) do { _Pragma("unroll") for (int m = 0; m < 4; ++m) _Pragma("unroll") for (int k = 0; k < 2; ++k) dst[m][k] = *(const LAS bf16x8*)(lds + PG8_SA(b, h) + aoff + m * 2048 + k * 1024); } while (0)
#define PG8_LDB(dst, b, h) do { _Pragma("unroll") for (int n = 0; n < 2; ++n) _Pragma("unroll") for (int k = 0; k < 2; ++k) dst[n][k] = *(const LAS bf16x8*)(lds + PG8_SB(b, h) + boff + n * 2048 + k * 1024); } while (0)
#define PG8_MMA(ai, bj, At, Bt) do { __builtin_amdgcn_s_setprio(1); _Pragma("unroll") for (int m = 0; m < 4; ++m) _Pragma("unroll") for (int n = 0; n < 2; ++n) _Pragma("unroll") for (int k = 0; k < 2; ++k) \
        acc[ai][bj][m][n] = __builtin_amdgcn_mfma_f32_16x16x32_bf16(Bt[n][k], At[m][k], acc[ai][bj][m][n], 0, 0, 0); __builtin_amdgcn_s_setprio(0); } while (0)
#define PG8_WAIT_V(n) asm volatile("s_waitcnt vmcnt(" #n ")" ::: "memory")
#define PG8_WAIT_L(n) asm volatile("s_waitcnt lgkmcnt(" #n ")" ::: "memory")
#define PG8_BAR __builtin_amdgcn_s_barrier()
#define PG8_SCHED __builtin_amdgcn_sched_barrier(0)
    Unit cur, nxt; int ui = 0;
    if (!S.next(0, cur)) return;
    f32x4 acc[2][2][4][2];
#pragma unroll
    for (int a = 0; a < 2; ++a)
#pragma unroll
        for (int b = 0; b < 2; ++b)
#pragma unroll
            for (int m = 0; m < 4; ++m)
#pragma unroll
                for (int n = 0; n < 2; ++n) acc[a][b][m][n] = (f32x4){0.f, 0.f, 0.f, 0.f};
    bf16x8 At[4][2], B0[2][2], B1[2][2];
    const char* cA = (const char*)g.A + (size_t)cur.pm * tstepA + (size_t)cur.kb * kbstep; const char* cB = (const char*)g.Bt + (size_t)cur.pn * tstepB + (size_t)cur.kb * kbstep;
    PG8_STAGE(PG8_SB(0, 0), cB, voffB); PG8_STAGE(PG8_SB(0, 1), cB + hstepB, voffB); PG8_STAGE(PG8_SA(0, 0), cA, voffA); PG8_STAGE(PG8_SA(0, 1), cA + hstepA, voffA);
    if (wr == 1) PG8_BAR;
    PG8_WAIT_V(2); PG8_BAR;
    PG8_STAGE(PG8_SB(1, 0), cB + kstep, voffB); PG8_STAGE(PG8_SA(1, 0), cA + kstep, voffA); PG8_STAGE(PG8_SB(1, 1), cB + hstepB + kstep, voffB);
    PG8_WAIT_V(6); PG8_BAR;
    for (;;) {
        const bool has_next = S.next(ui + 1, nxt);
        const char* nA = has_next ? (const char*)g.A + (size_t)nxt.pm * tstepA + (size_t)nxt.kb * kbstep : cA;
        const char* nB = has_next ? (const char*)g.Bt + (size_t)nxt.pn * tstepB + (size_t)nxt.kb * kbstep : cB;
        for (int t = 0; t < nt; t += 2) {
            const bool last = (t == nt - 2);
            const char* a1 = cA + (size_t)(t + 1) * kstep;
            const char* a2 = last ? nA : cA + (size_t)(t + 2) * kstep; const char* b2 = last ? nB : cB + (size_t)(t + 2) * kstep;
            const char* a3 = a2 + kstep; const char* b3 = b2 + kstep;
            PG8_LDB(B0, 0, 0); PG8_LDB(B1, 0, 1); PG8_SCHED; PG8_LDA(At, 0, 0); PG8_STAGE(PG8_SA(1, 1), a1 + hstepA, voffA);
            PG8_WAIT_V(8); PG8_WAIT_L(0); PG8_BAR; PG8_MMA(0, 0, At, B0); PG8_MMA(0, 1, At, B1); PG8_BAR; PG8_SCHED;
            PG8_LDA(At, 0, 1); PG8_STAGE(PG8_SB(0, 0), b2, voffB); PG8_STAGE(PG8_SB(0, 1), b2 + hstepB, voffB); PG8_STAGE(PG8_SA(0, 0), a2, voffA);
            PG8_WAIT_V(8); PG8_WAIT_L(0); PG8_BAR; PG8_MMA(1, 0, At, B0); PG8_MMA(1, 1, At, B1); PG8_BAR; PG8_SCHED;
            PG8_LDB(B0, 1, 0); PG8_LDB(B1, 1, 1); PG8_SCHED; PG8_LDA(At, 1, 0); PG8_STAGE(PG8_SA(0, 1), a2 + hstepA, voffA);
            PG8_WAIT_V(8); PG8_WAIT_L(0); PG8_BAR; PG8_MMA(0, 0, At, B0); PG8_MMA(0, 1, At, B1); PG8_BAR; PG8_SCHED;
            PG8_LDA(At, 1, 1); PG8_STAGE(PG8_SB(1, 0), b3, voffB); PG8_STAGE(PG8_SB(1, 1), b3 + hstepB, voffB); PG8_STAGE(PG8_SA(1, 0), a3, voffA);
            PG8_WAIT_V(8); PG8_WAIT_L(0); PG8_BAR; PG8_MMA(1, 0, At, B0); PG8_MMA(1, 1, At, B1); PG8_BAR; PG8_SCHED;
        }
        if (wr == 0) PG8_BAR;
        E(acc, cur, wr, wc, fr, fq);
        if (!has_next) break;
#pragma unroll
        for (int a = 0; a < 2; ++a)
#pragma unroll
            for (int b = 0; b < 2; ++b)
#pragma unroll
                for (int m = 0; m < 4; ++m)
#pragma unroll
                    for (int n = 0; n < 2; ++n) acc[a][b][m][n] = (f32x4){0.f, 0.f, 0.f, 0.f};
        cur = nxt; cA = nA; cB = nB; ++ui;
        if (wr == 1) PG8_BAR;
    }
    PG8_WAIT_V(0);
    PG8_BAR;
#undef PG8_SA
#undef PG8_SB
#undef PG8_STAGE
#undef PG8_LDA
#undef PG8_LDB
#undef PG8_MMA
#undef PG8_WAIT_V
#undef PG8_WAIT_L
#undef PG8_BAR
#undef PG8_SCHED
}
}

struct Args { const float* in[30]; float* out; unsigned char* ws; int ph_lo, ph_hi; };
enum { I_XP = 0, I_XS, I_SCONV, I_SSSM, I_SHGRN, I_SGLA, I_F1N, I_F1GU, I_F1D, I_MIXN, I_WIN, I_CONVW, I_CONVB, I_DTB, I_ALOG, I_DSKIP, I_MNORM, I_LBL, I_HNORM, I_GWD, I_GBD, I_GNORM,
       I_WBM, I_WBH, I_WBG, I_WOUT, I_F2N, I_F2GU, I_F2D, I_FINN };

__device__ __forceinline__ int map_col(int map, int np) {
    if (map == 0) return np;
    if (map == 1) { const int pn = np >> 8, w = np & 255; return w < 128 ? 128 * pn + w : DFF + 128 * pn + (w - 128); }
    if (np < 2560) return np;
    if (np < PC_GATE) return np + 16;
    if (np < PC_DT) return np + 32;
    if (np < PC_GA) return 2560 + (np - PC_DT);
    if (np < INC) return 9744 + (np - PC_GA);
    return -1;
}
struct TrItem { const float* W; const float* kscale; bf16_t* WT; int N, ldk, koff, map, k0, n0; };
__device__ __forceinline__ void tr_load(const TrItem& T, int tid, f32x4 (&v)[8]) {
    const int c4 = (tid & 31) * 4, src = map_col(T.map, T.n0 + c4);
#pragma unroll
    for (int i = 0; i < 8; ++i) { const int r = (tid >> 5) + 16 * i; v[i] = (f32x4){0.f, 0.f, 0.f, 0.f};
        if (src >= 0) { v[i] = *(const f32x4*)(T.W + (size_t)(T.k0 + r) * T.N + src); if (T.kscale) v[i] = v[i] * T.kscale[T.k0 + r]; } }
}
__device__ __forceinline__ void tr_store(const TrItem& T, int tid, const f32x4 (&v)[8], LAS float* tile) {
    const int c4 = (tid & 31) * 4;
#pragma unroll
    for (int i = 0; i < 8; ++i) { const int r = (tid >> 5) + 16 * i; LAS float* p = tile + r * 129 + c4; p[0] = v[i][0]; p[1] = v[i][1]; p[2] = v[i][2]; p[3] = v[i][3]; }
    LDS_WAIT(); __syncthreads();
    const int kg = tid & 15;
#pragma unroll
    for (int j = 0; j < 4; ++j) { const int n = (tid >> 4) + 32 * j; const LAS float* sp = tile + (8 * kg) * 129 + n;
        u32x4 o; o.x = pk2(sp[0], sp[129]); o.y = pk2(sp[2 * 129], sp[3 * 129]); o.z = pk2(sp[4 * 129], sp[5 * 129]); o.w = pk2(sp[6 * 129], sp[7 * 129]);
        *(u32x4*)(T.WT + (size_t)(T.n0 + n) * T.ldk + T.koff + T.k0 + 8 * kg) = o; }
    LDS_WAIT(); __syncthreads();
}
__device__ __forceinline__ TrItem tr_item(const Args& a, int it) {
    constexpr int IT_GU = 16 * 88, IT_D = 44 * 16, IT_IN = 16 * 126, IT_B = 8 * 16, IT_O = 16 * 16;
    constexpr int IT_LAYER = 2 * IT_GU + 2 * IT_D + IT_IN + 3 * IT_B + IT_O;
    const int l = it / IT_LAYER; int r = it - l * IT_LAYER;
    unsigned char* wl = a.ws + WS_W + (size_t)l * WL_STRIDE;
    TrItem T; int nblk;
    if (r < IT_GU) { T = TrItem{a.in[I_F1GU] + (size_t)l * DM * 2 * DFF, a.in[I_F1N] + l * DM, (bf16_t*)(wl + WL_GU1), 2 * DFF, DM, 0, 1, 0, 0}; nblk = 88; }
    else if ((r -= IT_GU) < IT_D) { T = TrItem{a.in[I_F1D] + (size_t)l * DFF * DM, nullptr, (bf16_t*)(wl + WL_D1), DM, DFF, 0, 0, 0, 0}; nblk = 16; }
    else if ((r -= IT_D) < IT_IN) { T = TrItem{a.in[I_WIN] + (size_t)l * DM * INC, a.in[I_MIXN] + l * DM, (bf16_t*)(wl + WL_IN), INC, DM, 0, 2, 0, 0}; nblk = 126; }
    else if ((r -= IT_IN) < IT_B) { T = TrItem{a.in[I_WBM] + (size_t)l * 1024 * DM, nullptr, (bf16_t*)(wl + WL_BR), DM, 3072, 0, 0, 0, 0}; nblk = 16; }
    else if ((r -= IT_B) < IT_B) { T = TrItem{a.in[I_WBH] + (size_t)l * 1024 * DM, nullptr, (bf16_t*)(wl + WL_BR), DM, 3072, 1024, 0, 0, 0}; nblk = 16; }
    else if ((r -= IT_B) < IT_B) { T = TrItem{a.in[I_WBG] + (size_t)l * 1024 * DM, nullptr, (bf16_t*)(wl + WL_BR), DM, 3072, 2048, 0, 0, 0}; nblk = 16; }
    else if ((r -= IT_B) < IT_O) { T = TrItem{a.in[I_WOUT] + (size_t)l * DM * DM, nullptr, (bf16_t*)(wl + WL_OUT), DM, DM, 0, 0, 0, 0}; nblk = 16; }
    else if ((r -= IT_O) < IT_GU) { T = TrItem{a.in[I_F2GU] + (size_t)l * DM * 2 * DFF, a.in[I_F2N] + l * DM, (bf16_t*)(wl + WL_GU2), 2 * DFF, DM, 0, 1, 0, 0}; nblk = 88; }
    else { r -= IT_GU; T = TrItem{a.in[I_F2D] + (size_t)l * DFF * DM, nullptr, (bf16_t*)(wl + WL_D2), DM, DFF, 0, 0, 0, 0}; nblk = 16; }
    T.k0 = 128 * (r / nblk); T.n0 = 128 * (r % nblk);
    return T;
}
constexpr int TR_ITEMS = DEPTH * (2 * 16 * 88 + 2 * 44 * 16 + 16 * 126 + 3 * 8 * 16 + 16 * 16);

struct Ctx {
    LAS unsigned char* lds; const Args* a; unsigned char* ws; int tid, lane, wave, G, gw, NGW;
};

__device__ __forceinline__ void phase_prologue(const Args& a, LAS unsigned char* lds) {
    int tid = threadIdx.x; asm volatile("" : "+v"(tid));
    const int lane = tid & 63, wave = __builtin_amdgcn_readfirstlane(tid >> 6), gw = blockIdx.x * 8 + wave, NGW = gridDim.x * 8;
    unsigned char* ws = a.ws;
    { LAS float* tile = (LAS float*)lds; const int G = gridDim.x;
      int it = blockIdx.x; f32x4 v[8];
      if (it < TR_ITEMS) { const TrItem T = tr_item(a, it); tr_load(T, tid, v); }
      while (it < TR_ITEMS) {
          const TrItem T = tr_item(a, it); f32x4 cur[8];
#pragma unroll
          for (int i = 0; i < 8; ++i) cur[i] = v[i];
          const int nx = it + G;
          if (nx < TR_ITEMS) { const TrItem Tn = tr_item(a, nx); tr_load(Tn, tid, v); }
          tr_store(T, tid, cur, tile);
          it = nx;
      } }
    float* X = (float*)(ws + WS_X); bf16_t* XB = (bf16_t*)(ws + WS_XB); float* ssq0 = (float*)(ws + WS_CTL + CTL_SSQ);
    for (int r = gw; r < MP; r += NGW) {
        const float* src = r < NPROMPT ? a.in[I_XP] + (size_t)r * DM : (r < NTOK ? a.in[I_XS] + (size_t)(r - NPROMPT) * DM : nullptr);
        float ss = 0.f;
#pragma unroll
        for (int j = 0; j < 8; ++j) { f32x4 v = (f32x4){0.f, 0.f, 0.f, 0.f}; if (src) v = *(const f32x4*)(src + 4 * lane + 256 * j);
            *(f32x4*)(X + (size_t)r * DM + 4 * lane + 256 * j) = v; ss += (v[0] * v[0] + v[1] * v[1]) + (v[2] * v[2] + v[3] * v[3]);
            u32x2 w; w.x = pk2(v[0], v[1]); w.y = pk2(v[2], v[3]); *(u32x2*)(XB + (size_t)r * DM + 4 * lane + 256 * j) = w; }
        ss = wave_sum(ss); if (lane == 0) ssq0[r] = ss;
        if (r >= NTOK) { bf16_t* y = (bf16_t*)(ws + WS_Y) + (size_t)r * 3072;
#pragma unroll
            for (int j = 0; j < 6; ++j) *(u32x4*)(y + 8 * lane + 512 * j) = (u32x4){0u, 0u, 0u, 0u}; }
    }
    float* LB = (float*)(ws + WS_LB);
    for (int c = gw * 64 + lane; c < 1024; c += NGW * 64) {
        float mx = -1e30f; for (int l = 0; l < DEPTH; ++l) mx = fmaxf(mx, a.in[I_LBL][l * 1024 + c]);
        float den = 0.f; for (int l = 0; l < DEPTH; ++l) den += expf(a.in[I_LBL][l * 1024 + c] - mx);
        float cum = 0.f; const float sm0 = expf(a.in[I_LBL][c] - mx) / den;
        for (int l = 0; l < DEPTH; ++l) { cum += expf(a.in[I_LBL][l * 1024 + c] - mx) / den; LB[l * 1024 + c] = cum - sm0; }
    }
}

__device__ __forceinline__ void unpack8(const u32x4 w, float (&x)[8]) {
#pragma unroll
    for (int j = 0; j < 4; ++j) { x[2 * j] = bf2f(w[j] & 0xffffu); x[2 * j + 1] = bf2f(w[j] >> 16); }
}
__device__ __forceinline__ void phase_prep(const Args& a, int l, LAS unsigned char* lds) {
    int tid = threadIdx.x; asm volatile("" : "+v"(tid));
    const int lane = tid & 63, wave = __builtin_amdgcn_readfirstlane(tid >> 6), gw = blockIdx.x * 8 + wave, NGW = gridDim.x * 8;
    unsigned char* ws = a.ws;
    const bf16_t* PROJ = (const bf16_t*)(ws + WS_PROJ); bf16_t* XC = (bf16_t*)(ws + WS_XC); float* DT = (float*)(ws + WS_DT); float* LGA = (float*)(ws + WS_LGA);
    LAS float* swd = (LAS float*)lds;
    for (int i = tid; i < 16 * 512; i += 512) swd[i] = a.in[I_GWD][(size_t)l * 16 * 512 + i];
    for (int i = tid; i < 512; i += 512) swd[8192 + i] = a.in[I_GBD][l * 512 + i];
    __syncthreads();
    const float* cw = a.in[I_CONVW] + (size_t)l * 4 * 1536; const float* cb = a.in[I_CONVB] + l * 1536;
    for (int r = gw; r < NTOK; r += NGW) {
        const bool samp = r >= NPROMPT; const int t = samp ? 0 : (r & (SEQ - 1)), s = r - NPROMPT, b = r >> 11;
        const bf16_t* prow = PROJ + (size_t)r * INP;
#pragma unroll 1
        for (int i = 0; i < 3; ++i) {
            const int ch = lane * 8 + 512 * i;
            float c[8], x[8];
            { const f32x4 b0 = *(const f32x4*)(cb + ch), b1 = *(const f32x4*)(cb + ch + 4);
#pragma unroll
              for (int j = 0; j < 4; ++j) { c[j] = b0[j]; c[4 + j] = b1[j]; } }
            unpack8(*(const u32x4*)(prow + PC_XBC + ch), x);
            { const f32x4 w0 = *(const f32x4*)(cw + 3 * 1536 + ch), w1 = *(const f32x4*)(cw + 3 * 1536 + ch + 4);
#pragma unroll
              for (int j = 0; j < 4; ++j) { c[j] += w0[j] * x[j]; c[4 + j] += w1[j] * x[4 + j]; } }
            if (samp) { float* op = a.out + O_CS + (((size_t)l * NSAMP + s) * 3 + 2) * 1536 + ch; *(f32x4*)op = (f32x4){x[0], x[1], x[2], x[3]}; *(f32x4*)(op + 4) = (f32x4){x[4], x[5], x[6], x[7]}; }
            else if (t >= SEQ - 3) { float* op = a.out + O_CP + (((size_t)l * NB + b) * 3 + (t - (SEQ - 3))) * 1536 + ch; *(f32x4*)op = (f32x4){x[0], x[1], x[2], x[3]}; *(f32x4*)(op + 4) = (f32x4){x[4], x[5], x[6], x[7]}; }
#pragma unroll
            for (int k = 1; k <= 3; ++k) {
                if (samp) { const float* sp = a.in[I_SCONV] + (((size_t)l * NSAMP + s) * 3 + (3 - k)) * 1536 + ch; const f32x4 p0 = *(const f32x4*)sp, p1 = *(const f32x4*)(sp + 4);
#pragma unroll
                    for (int j = 0; j < 4; ++j) { x[j] = p0[j]; x[4 + j] = p1[j]; }
                    if (k <= 2) { float* op = a.out + O_CS + (((size_t)l * NSAMP + s) * 3 + (2 - k)) * 1536 + ch; *(f32x4*)op = p0; *(f32x4*)(op + 4) = p1; } }
                else if (t - k >= 0) unpack8(*(const u32x4*)(prow - (size_t)k * INP + PC_XBC + ch), x);
                else {
#pragma unroll
                    for (int j = 0; j < 8; ++j) x[j] = 0.f; }
                const f32x4 w0 = *(const f32x4*)(cw + (3 - k) * 1536 + ch), w1 = *(const f32x4*)(cw + (3 - k) * 1536 + ch + 4);
#pragma unroll
                for (int j = 0; j < 4; ++j) { c[j] += w0[j] * x[j]; c[4 + j] += w1[j] * x[4 + j]; }
            }
            u32x4 w; w.x = pk2(siluf_(c[0]), siluf_(c[1])); w.y = pk2(siluf_(c[2]), siluf_(c[3])); w.z = pk2(siluf_(c[4]), siluf_(c[5])); w.w = pk2(siluf_(c[6]), siluf_(c[7]));
            *(u32x4*)(XC + (size_t)r * 1536 + ch) = w;
        }
        if (lane < 16) DT[(size_t)r * 16 + lane] = softplusf_(bf2f(prow[PC_DT + lane]) + a.in[I_DTB][l * 16 + lane]);
        { float ga[16];
          unpack8(*(const u32x4*)(prow + PC_GA), *(float(*)[8])&ga[0]); unpack8(*(const u32x4*)(prow + PC_GA + 8), *(float(*)[8])&ga[8]);
          float pre[8];
#pragma unroll
          for (int e = 0; e < 8; ++e) pre[e] = swd[8192 + lane * 8 + e];
#pragma unroll
          for (int i = 0; i < 16; ++i)
#pragma unroll
              for (int e = 0; e < 8; ++e) pre[e] += ga[i] * swd[i * 512 + lane * 8 + e];
          float lo[8];
#pragma unroll
          for (int e = 0; e < 8; ++e) lo[e] = -(fmaxf(-pre[e], 0.f) + log1pf(__expf(-fabsf(pre[e])))) * (1.0f / 16.0f);
          float* op = LGA + (size_t)r * 512 + lane * 8;
          *(f32x4*)op = (f32x4){lo[0], lo[1], lo[2], lo[3]}; *(f32x4*)(op + 4) = (f32x4){lo[4], lo[5], lo[6], lo[7]}; }
    }
}

constexpr int TCH = 16;
struct ScanUnit { int mix, seq, h, j0, L, row0; bool samp; };
__device__ __forceinline__ void scan_unit(const Args& a, int l, const ScanUnit& U, LAS unsigned char* lds, const int tid, const int lane, const int wave) {
    unsigned char* ws = a.ws;
    const bf16_t* PROJ = (const bf16_t*)(ws + WS_PROJ); const bf16_t* XC = (const bf16_t*)(ws + WS_XC); const float* DT = (const float*)(ws + WS_DT); const float* LGA = (const float*)(ws + WS_LGA);
    float* O = (float*)(ws + WS_O); const float* LB = (const float*)(ws + WS_LB) + l * 1024;
    LAS float* sq = (LAS float*)lds;
    LAS float* sk = sq + 2 * TCH * 128;
    LAS float* sd = sk + 2 * TCH * 128;
    LAS float* sv = sd + 2 * TCH * 128;
    LAS float* sx = sv + 2 * TCH * 64;
    LAS float* red = sx + 2 * TCH * 64;
    const int mix = U.mix, h = U.h, j0 = U.j0;
    const int d = tid & 127;
    float cA = 0.f, cB = 0.f;
    if (mix == 0) cA = -__expf(a.in[I_ALOG][l * 16 + h]);
    if (mix == 1) cA = LB[h * 128 + d];
    const float dskip = (mix == 0) ? a.in[I_DSKIP][l * 16 + h] : 0.f;
    (void)cB;
    float S[16];
    size_t sbase; int sstride_dk, sstride_dv;
    const float* sin = nullptr; float* sout;
    if (mix == 0) { sstride_dk = 1; sstride_dv = 128;
        if (U.samp) { sbase = (((size_t)l * NSAMP + U.seq) * 16 + h) * 8192; sin = a.in[I_SSSM] + sbase; sout = a.out + O_SS + sbase; }
        else { sbase = (((size_t)l * NB + U.seq) * 16 + h) * 8192; sout = a.out + O_SP + sbase; } }
    else if (mix == 1) { sstride_dk = 128; sstride_dv = 1;
        if (U.samp) { sbase = (((size_t)l * NSAMP + U.seq) * 8 + h) * 16384; sin = a.in[I_SHGRN] + sbase; sout = a.out + O_HS + sbase; }
        else { sbase = (((size_t)l * NB + U.seq) * 8 + h) * 16384; sout = a.out + O_HP + sbase; } }
    else { sstride_dk = 256; sstride_dv = 1;
        if (U.samp) { sbase = (((size_t)l * NSAMP + U.seq) * 4 + h) * 32768; sin = a.in[I_SGLA] + sbase; sout = a.out + O_GS + sbase; }
        else { sbase = (((size_t)l * NB + U.seq) * 4 + h) * 32768; sout = a.out + O_GP + sbase; } }
    const size_t soff = (size_t)(wave * 16) * sstride_dk + (size_t)(j0 + lane) * sstride_dv;
#pragma unroll
    for (int i = 0; i < 16; ++i) S[i] = sin ? sin[soff + (size_t)i * sstride_dk] : 0.f;

    const int nch = (U.L + TCH - 1) / TCH;
    unsigned r0[4], r1[4]; float rx[4]; unsigned rv[2]; float rdt[2];
#define LOAD_RAW(c) do { \
    _Pragma("unroll") \
        for (int ii = 0; ii < 4; ++ii) { const int tk = (tid >> 7) + 4 * ii, t = (c) * TCH + tk; r0[ii] = 0; r1[ii] = 0; rx[ii] = 0.f; \
            if (t < U.L) { const size_t r = (size_t)U.row0 + t; \
                if (mix == 0) { const int grp = h >> 3; r0[ii] = XC[r * 1536 + 1280 + grp * 128 + d]; r1[ii] = XC[r * 1536 + 1024 + grp * 128 + d]; rx[ii] = DT[r * 16 + h]; } \
                else if (mix == 1) { r0[ii] = PROJ[r * INP + PC_HQ + h * 128 + d]; r1[ii] = PROJ[r * INP + PC_HF + h * 128 + d]; } \
                else { r0[ii] = PROJ[r * INP + PC_GQ + h * 128 + d]; r1[ii] = PROJ[r * INP + PC_GK + h * 128 + d]; rx[ii] = LGA[r * 512 + h * 128 + d]; } } } \
    _Pragma("unroll") \
        for (int ii = 0; ii < 2; ++ii) { const int tk = wave + 8 * ii, t = (c) * TCH + tk; rv[ii] = 0; rdt[ii] = 0.f; \
            if (t < U.L) { const size_t r = (size_t)U.row0 + t; \
                if (mix == 0) { rv[ii] = XC[r * 1536 + h * 64 + lane]; rdt[ii] = DT[r * 16 + h]; } \
                else if (mix == 1) rv[ii] = PROJ[r * INP + PC_HI + h * 128 + j0 + lane]; \
                else rv[ii] = PROJ[r * INP + PC_GV + h * 256 + j0 + lane]; } } \
} while (0)
#define STORE_LDS(p) do { \
    _Pragma("unroll") \
        for (int ii = 0; ii < 4; ++ii) { const int tk = (tid >> 7) + 4 * ii; const int o = ((p) * TCH + tk) * 128 + d; const float v0 = bf2f(r0[ii]), v1 = bf2f(r1[ii]); \
            if (mix == 0) { sq[o] = v0; sk[o] = v1; sd[o] = __expf(rx[ii] * cA); } \
            else if (mix == 1) { sq[o] = siluf_(v0) * 0.08838834764831845f; const float sg = sigmoidf_(v1); sd[o] = cA + (1.f - cA) * sg; sk[o] = (1.f - cA) * fast_rcp(1.f + __expf(v1)); } \
            else { sq[o] = v0 * 0.08838834764831845f; sk[o] = v1; sd[o] = __expf(rx[ii]); } } \
    _Pragma("unroll") \
        for (int ii = 0; ii < 2; ++ii) { const int tk = wave + 8 * ii; const int o = ((p) * TCH + tk) * 64 + lane; const float v = bf2f(rv[ii]); \
            if (mix == 0) { sv[o] = v * rdt[ii]; sx[o] = v; } else { sv[o] = v; sx[o] = 0.f; } } \
} while (0)
    __syncthreads();
    LOAD_RAW(0); STORE_LDS(0);
    __syncthreads();
    for (int c = 0; c < nch; ++c) {
        const int p = c & 1; const int ntok = min(TCH, U.L - c * TCH);
        if (c + 1 < nch) LOAD_RAW(c + 1);
        for (int tk = 0; tk < ntok; ++tk) {
            const float v = sv[(p * TCH + tk) * 64 + lane]; float accv = 0.f;
            const LAS f32x4* q4 = (const LAS f32x4*)(sq + (p * TCH + tk) * 128 + wave * 16);
            const LAS f32x4* k4 = (const LAS f32x4*)(sk + (p * TCH + tk) * 128 + wave * 16);
            const LAS f32x4* d4 = (const LAS f32x4*)(sd + (p * TCH + tk) * 128 + wave * 16);
#pragma unroll
            for (int i4 = 0; i4 < 4; ++i4) { const f32x4 qq = q4[i4], kk = k4[i4], dd = d4[i4];
#pragma unroll
                for (int e = 0; e < 4; ++e) { S[i4 * 4 + e] = dd[e] * S[i4 * 4 + e] + kk[e] * v; accv += qq[e] * S[i4 * 4 + e]; } }
            red[(tk * 8 + wave) * 64 + lane] = accv;
        }
        __syncthreads();
#pragma unroll
        for (int ii = 0; ii < 2; ++ii) { const int tk = wave + 8 * ii;
            if (tk < ntok) { float o = 0.f;
#pragma unroll
                for (int gq = 0; gq < 8; ++gq) o += red[(tk * 8 + gq) * 64 + lane];
                o += dskip * sx[(p * TCH + tk) * 64 + lane];
                const size_t r = (size_t)U.row0 + c * TCH + tk;
                const int col = mix == 0 ? h * 64 + lane : (mix == 1 ? 1024 + h * 128 + j0 + lane : 2048 + h * 256 + j0 + lane);
                O[r * 3072 + col] = o; } }
        if (c + 1 < nch) STORE_LDS(p ^ 1);
        __syncthreads();
    }
#pragma unroll
    for (int i = 0; i < 16; ++i) sout[soff + (size_t)i * sstride_dk] = S[i];
}
#undef LOAD_RAW
#undef STORE_LDS
__device__ __forceinline__ void phase_scan(const Args& a, int l, LAS unsigned char* lds) {
    int tid = threadIdx.x; asm volatile("" : "+v"(tid));
    const int lane = tid & 63, wave = __builtin_amdgcn_readfirstlane(tid >> 6), G = gridDim.x;
    const int w = blockIdx.x;
    constexpr int NPU = 192, NSU = 6144;
    const int nsw = G - NPU > 0 ? G - NPU : G;
    if (w < NPU) { const int mix = w / 64, rem = w % 64, b = rem / 16, hs = rem % 16; ScanUnit U; U.mix = mix; U.seq = b; U.samp = false; U.L = SEQ; U.row0 = b * SEQ;
        if (mix == 0) { U.h = hs; U.j0 = 0; } else if (mix == 1) { U.h = hs >> 1; U.j0 = 64 * (hs & 1); } else { U.h = hs >> 2; U.j0 = 64 * (hs & 3); }
        scan_unit(a, l, U, lds, tid, lane, wave); }
    const int sw = (G > NPU) ? w - NPU : w;
    if (sw >= 0) for (int su = sw; su < NSU; su += nsw) { const int mix = su / 2048, rem = su % 2048, s = rem / 16, hs = rem % 16; ScanUnit U; U.mix = mix; U.seq = s; U.samp = true; U.L = 1; U.row0 = NPROMPT + s;
        if (mix == 0) { U.h = hs; U.j0 = 0; } else if (mix == 1) { U.h = hs >> 1; U.j0 = 64 * (hs & 1); } else { U.h = hs >> 2; U.j0 = 64 * (hs & 3); }
        scan_unit(a, l, U, lds, tid, lane, wave); }
}

__device__ __forceinline__ void phase_post(const Args& a, int l) {
    int tid = threadIdx.x; asm volatile("" : "+v"(tid));
    const int lane = tid & 63, wave = __builtin_amdgcn_readfirstlane(tid >> 6), gw = blockIdx.x * 8 + wave, NGW = gridDim.x * 8;
    unsigned char* ws = a.ws;
    const bf16_t* PROJ = (const bf16_t*)(ws + WS_PROJ); const float* O = (const float*)(ws + WS_O); bf16_t* Y = (bf16_t*)(ws + WS_Y);
    const float* mnw = a.in[I_MNORM] + l * 1024; const float* hnw = a.in[I_HNORM] + l * 128; const float* gnw = a.in[I_GNORM] + l * 256;
    for (int r = gw; r < NTOK; r += NGW) {
        const float* orow = O + (size_t)r * 3072; const bf16_t* prow = PROJ + (size_t)r * INP; bf16_t* yrow = Y + (size_t)r * 3072;
#pragma unroll
        for (int g = 0; g < 2; ++g) { const int c0 = g * 512 + lane * 8; float y[8]; float ss = 0.f;
            const f32x4 o0 = *(const f32x4*)(orow + c0), o1 = *(const f32x4*)(orow + c0 + 4); const u32x4 zw = *(const u32x4*)(prow + PC_Z + c0);
#pragma unroll
            for (int j = 0; j < 4; ++j) { y[2 * j] = (j < 2 ? o0[2 * j] : o1[2 * j - 4]) * siluf_(bf2f(zw[j] & 0xffffu)); y[2 * j + 1] = (j < 2 ? o0[2 * j + 1] : o1[2 * j - 3]) * siluf_(bf2f(zw[j] >> 16)); }
#pragma unroll
            for (int j = 0; j < 8; ++j) ss += y[j] * y[j];
            ss = wave_sum(ss); const float rs = rsqrtf(ss * (1.0f / 512.0f) + EPS);
            u32x4 w; w.x = pk2(y[0] * rs * mnw[c0], y[1] * rs * mnw[c0 + 1]); w.y = pk2(y[2] * rs * mnw[c0 + 2], y[3] * rs * mnw[c0 + 3]); w.z = pk2(y[4] * rs * mnw[c0 + 4], y[5] * rs * mnw[c0 + 5]); w.w = pk2(y[6] * rs * mnw[c0 + 6], y[7] * rs * mnw[c0 + 7]);
            *(u32x4*)(yrow + c0) = w; }
#pragma unroll
        for (int hh = 0; hh < 8; ++hh) { const int c0 = hh * 128 + lane * 2; const f32x2 o = *(const f32x2*)(orow + 1024 + c0); const unsigned gwv = *(const unsigned*)(prow + PC_HG + c0);
            float ss = wave_sum(o[0] * o[0] + o[1] * o[1]); const float rs = rsqrtf(ss * (1.0f / 128.0f) + EPS);
            *(unsigned*)(yrow + 1024 + c0) = pk2(o[0] * rs * hnw[lane * 2] * siluf_(bf2f(gwv & 0xffffu)), o[1] * rs * hnw[lane * 2 + 1] * siluf_(bf2f(gwv >> 16))); }
#pragma unroll
        for (int hh = 0; hh < 4; ++hh) { const int c0 = hh * 256 + lane * 4; const f32x4 o = *(const f32x4*)(orow + 2048 + c0); const u32x2 gwv = *(const u32x2*)(prow + PC_GG + c0);
            float ss = wave_sum((o[0] * o[0] + o[1] * o[1]) + (o[2] * o[2] + o[3] * o[3])); const float rs = rsqrtf(ss * (1.0f / 256.0f) + EPS);
            u32x2 w; w.x = pk2(o[0] * rs * gnw[lane * 4] * siluf_(bf2f(gwv.x & 0xffffu)), o[1] * rs * gnw[lane * 4 + 1] * siluf_(bf2f(gwv.x >> 16)));
            w.y = pk2(o[2] * rs * gnw[lane * 4 + 2] * siluf_(bf2f(gwv.y & 0xffffu)), o[3] * rs * gnw[lane * 4 + 3] * siluf_(bf2f(gwv.y >> 16)));
            *(u32x2*)(yrow + 2048 + c0) = w; }
    }
}

__device__ __forceinline__ void phase_final(const Args& a) {
    int tid = threadIdx.x; asm volatile("" : "+v"(tid));
    const int lane = tid & 63, wave = __builtin_amdgcn_readfirstlane(tid >> 6), gw = blockIdx.x * 8 + wave, NGW = gridDim.x * 8;
    const float* X = (const float*)(a.ws + WS_X); const float* ssq = (const float*)(a.ws + WS_CTL + CTL_SSQ) + (size_t)(3 * DEPTH) * MP; const float* fw = a.in[I_FINN];
    for (int r = gw; r < NTOK; r += NGW) {
        const float rs = rsqrtf(ssq[r] * (1.0f / DM) + EPS);
        float* o = r < NPROMPT ? a.out + O_YP + (size_t)r * DM : a.out + O_YS + (size_t)(r - NPROMPT) * DM;
#pragma unroll
        for (int j = 0; j < 8; ++j) { const f32x4 v = *(const f32x4*)(X + (size_t)r * DM + 4 * lane + 256 * j), w = *(const f32x4*)(fw + 4 * lane + 256 * j);
            *(f32x4*)(o + 4 * lane + 256 * j) = v * rs * w; }
    }
}

__global__ void __launch_bounds__(512, 2) fwd(Args args) {
    extern __shared__ __attribute__((aligned(16))) unsigned char lds_raw[];
    LAS unsigned char* lds = (LAS unsigned char*)lds_raw;
    volatile LAS unsigned* MISC = (volatile LAS unsigned*)(lds + MISC_OFF);
    const int G = gridDim.x;
    unsigned char* ws = args.ws;
    unsigned* ctl = (unsigned*)(ws + WS_CTL);
    for (int u = threadIdx.x; u < (LDS_BYTES - 131072) / 4; u += 512) ((LAS unsigned*)(lds + 131072))[u] = 0u;
    __syncthreads();
    XcdBarrier bar; bar.bar = ctl + CW_BAR; bar.x = 0; bar.st = nullptr;
    const int lo = args.ph_lo, hi = args.ph_hi;
    const bool multi = (hi - lo) > 1;
    if (multi) bar = xcd_barrier_post(ctl + CW_BAR, MISC + 8);
#define IN(k) (lo <= (k) && (k) < hi)
#define SEAM(k) do { if (IN(k) && IN((k) + 1)) xcd_barrier(bar); } while (0)
    float* ssq = (float*)(ws + WS_CTL + CTL_SSQ);
    float* X = (float*)(ws + WS_X); bf16_t* XB = (bf16_t*)(ws + WS_XB); bf16_t* ACT = (bf16_t*)(ws + WS_ACT); bf16_t* PROJ = (bf16_t*)(ws + WS_PROJ);
    bf16_t* Y = (bf16_t*)(ws + WS_Y); float* PART = (float*)(ws + WS_PART); bf16_t* MRG = (bf16_t*)(ws + WS_MRG);
    int ph = 0;
    if (PHON(0) && IN(ph)) { for (int rep = 0; rep < NREP(0); ++rep) phase_prologue(args, lds); } SEAM(ph); ++ph;
    for (int it = 0; it < 3 * DEPTH; ++it) {
        const int l = it / 3, kind = it - 3 * l;
        unsigned char* wl = ws + WS_W + (size_t)l * WL_STRIDE;
        if (kind != 1) {
            const int si = 3 * l + (kind == 0 ? 0 : 2);
            if (PHON(1) && IN(ph)) { pg8::Gemm g{XB, (const bf16_t*)(wl + (kind == 0 ? WL_GU1 : WL_GU2)), DM, DM, DM}; pg8::Order<1> S; S.init(MP / 256, 2 * DFF / 256, G, (int)blockIdx.x);
                pg8::EpiSwiGLU E{ACT, ssq + (size_t)si * MP}; pg8::gemm_phase(lds, g, S, E); } SEAM(ph); ++ph;
            if (PHON(2) && IN(ph)) { pg8::Gemm g{ACT, (const bf16_t*)(wl + (kind == 0 ? WL_D1 : WL_D2)), DFF, DFF, DFF}; pg8::Order<1> S; S.init(MP / 256, DM / 256, G, (int)blockIdx.x);
                pg8::EpiResid E{X, XB, ssq + (size_t)(si + 1) * MP, 0.5f}; pg8::gemm_phase(lds, g, S, E); } SEAM(ph); ++ph;
        } else {
            if (PHON(3) && IN(ph)) { pg8::Gemm g{XB, (const bf16_t*)(wl + WL_IN), DM, DM, DM}; pg8::Order<1> S; S.init(MP / 256, INP / 256, G, (int)blockIdx.x);
                pg8::EpiProj E{PROJ, ssq + (size_t)(3 * l + 1) * MP}; pg8::gemm_phase(lds, g, S, E); } SEAM(ph); ++ph;
            if (PHON(4) && IN(ph)) { for (int rep = 0; rep < NREP(4); ++rep) phase_prep(args, l, lds); } SEAM(ph); ++ph;
            if (PHON(5) && IN(ph)) { for (int rep = 0; rep < NREP(5); ++rep) phase_scan(args, l, lds); } SEAM(ph); ++ph;
            if (PHON(6) && IN(ph)) { for (int rep = 0; rep < NREP(6); ++rep) phase_post(args, l); } SEAM(ph); ++ph;
            if (PHON(7) && IN(ph)) { pg8::Gemm g{Y, (const bf16_t*)(wl + WL_BR), 3072, 3072, 1024}; pg8::Order<3> S; S.init(MP / 256, DM / 256, G, (int)blockIdx.x);
                pg8::EpiBranch E{PROJ, PART, MRG}; pg8::gemm_phase(lds, g, S, E); } SEAM(ph); ++ph;
            if (PHON(8) && IN(ph)) { pg8::Gemm g{MRG, (const bf16_t*)(wl + WL_OUT), DM, DM, DM}; pg8::Order<1> S; S.init(MP / 256, DM / 256, G, (int)blockIdx.x);
                pg8::EpiResid E{X, XB, ssq + (size_t)(3 * l + 2) * MP, 1.0f}; pg8::gemm_phase(lds, g, S, E); } SEAM(ph); ++ph;
        }
    }
    if (PHON(9) && IN(ph)) { phase_final(args); } ++ph;
#undef IN
#undef SEAM
}
constexpr int N_PHASES = 1 + DEPTH * 10 + 1;

extern "C" void kernel_launch(void* const* d_in, const int* in_sizes, int n_in, void* d_out, int out_size, void* d_ws, size_t ws_size, hipStream_t stream) {
    static int grid = 0;
    if (grid == 0) {
        if (n_in != 30 || (size_t)out_size != O_END || ws_size < WS_END) { fprintf(stderr, "kernel_launch: unexpected problem: n_in %d out %d ws %zu (need %zu)\n", n_in, out_size, ws_size, (size_t)WS_END); grid = -1; return; }
        int dev = 0, cus = 0, per_cu = 0;
        if (hipGetDevice(&dev) != hipSuccess || hipDeviceGetAttribute(&cus, hipDeviceAttributeMultiprocessorCount, dev) != hipSuccess) { grid = -1; return; }
        if (hipFuncSetAttribute((const void*)fwd, hipFuncAttributeMaxDynamicSharedMemorySize, LDS_BYTES) != hipSuccess) { fprintf(stderr, "kernel_launch: hipFuncSetAttribute failed\n"); grid = -1; return; }
        if (hipOccupancyMaxActiveBlocksPerMultiprocessor(&per_cu, (const void*)fwd, 512, LDS_BYTES) != hipSuccess || per_cu < 1) fprintf(stderr, "kernel_launch: occupancy query reports %d\n", per_cu);
        (void)hipGetLastError();
        grid = cus;
    }
    if (grid < 0) return;
    (void)hipMemsetAsync((char*)d_ws + WS_CTL, 0, CTL_ZERO_BYTES, stream);
    Args a{};
    for (int i = 0; i < 30; ++i) a.in[i] = (const float*)d_in[i];
    a.out = (float*)d_out; a.ws = (unsigned char*)d_ws;
#if MK_PER_PHASE
    for (int p = 0; p < N_PHASES; ++p) { a.ph_lo = p; a.ph_hi = p + 1; hipLaunchKernelGGL(fwd, dim3(grid), dim3(512), LDS_BYTES, stream, a); }
#else
    a.ph_lo = 0; a.ph_hi = N_PHASES; hipLaunchKernelGGL(fwd, dim3(grid), dim3(512), LDS_BYTES, stream, a);
#endif
}
```

```cpp
#include <hip/hip_runtime.h>
#include <cstdio>
#include <cstdint>

#ifndef PHMASK
#define PHMASK 0xFFFF
#endif
#define PHON(k) ((PHMASK >> (k)) & 1)
#ifndef REP_SITE
#define REP_SITE -1
#endif
#define NREP(k) ((REP_SITE == (k)) ? 2 : 1)
#ifndef MK_PER_PHASE
#define MK_PER_PHASE 0
#endif

#define LAS __attribute__((address_space(3)))
#define GAS __attribute__((address_space(1)))
typedef unsigned short bf16_t;
typedef short bf16x8 __attribute__((ext_vector_type(8)));
typedef float f32x4 __attribute__((ext_vector_type(4)));
typedef float f32x2 __attribute__((ext_vector_type(2)));
typedef unsigned u32x4 __attribute__((ext_vector_type(4)));
typedef unsigned u32x2 __attribute__((ext_vector_type(2)));

constexpr int DM = 2048, DFF = 5632, SEQ = 2048, NB = 4, NPROMPT = NB * SEQ, NSAMP = 128, NTOK = NPROMPT + NSAMP, MP = 8448  , DEPTH = 2;
constexpr int INC = 15904, INP = 16128;
constexpr float EPS = 1e-6f;
constexpr int PC_Z = 0, PC_XBC = 1024, PC_HQ = 2560, PC_HF = 3584, PC_HI = 4608, PC_HG = 5632, PC_GQ = 6656, PC_GK = 7168, PC_GV = 7680, PC_GG = 8704, PC_GATE = 9728, PC_DT = 15872, PC_GA = 15888;
constexpr size_t O_YP = 0, O_YS = 16777216, O_CP = 17039360, O_SP = 17076224, O_HP = 18124800, O_GP = 19173376, O_CS = 20221952, O_SS = 21401600, O_HS = 54956032, O_GS = 88510464, O_END = 122064896;

constexpr size_t MiB = 1u << 20;
constexpr size_t WS_CTL = 0, CTL_ZERO_BYTES = 1 * MiB;
constexpr size_t WS_LB = 1 * MiB, WS_DT = 2 * MiB, WS_LGA = 3 * MiB, WS_XC = 20 * MiB, WS_X = 45 * MiB, WS_XB = 111 * MiB, WS_ACT = 144 * MiB, WS_PROJ = 235 * MiB,
                 WS_O = 495 * MiB, WS_Y = 594 * MiB, WS_PART = 644 * MiB, WS_MRG = 710 * MiB, WS_W = 743 * MiB;
constexpr size_t WL_GU1 = 0, WL_D1 = 44 * MiB, WL_IN = 66 * MiB, WL_BR = 129 * MiB, WL_OUT = 141 * MiB, WL_GU2 = 149 * MiB, WL_D2 = 193 * MiB, WL_STRIDE = 215 * MiB;
constexpr size_t WS_END = WS_W + 2 * WL_STRIDE;
constexpr int CW_BAR = 4096;
constexpr size_t CTL_SSQ = 512 * 1024;
constexpr int LDS_BYTES = 147456;
constexpr int MISC_OFF = 131072 + 320;

__device__ __forceinline__ float bf2f(unsigned b) { return __uint_as_float(b << 16); }
__device__ __forceinline__ unsigned f2bf(float f) { unsigned u = __float_as_uint(f); return (u + 0x7fffu + ((u >> 16) & 1u)) >> 16; }

__device__ __forceinline__ unsigned cvt_pk_bf16(float lo, float hi) { typedef __bf16 bf2_ __attribute__((ext_vector_type(2))); f32x2 v = {lo, hi}; bf2_ r = __builtin_convertvector(v, bf2_); return __builtin_bit_cast(unsigned, r); }
__device__ __forceinline__ float fast_rcp(float x) { return __builtin_amdgcn_rcpf(x); }
__device__ __forceinline__ float sigmoidf_(float x) { return fast_rcp(1.0f + __expf(-x)); }
__device__ __forceinline__ float siluf_(float x) { return x * sigmoidf_(x); }
__device__ __forceinline__ float softplusf_(float x) { return x > 20.f ? x : log1pf(__expf(x)); }
__device__ __forceinline__ float wave_sum(float v) {
#pragma unroll
    for (int o = 1; o < 64; o <<= 1) v += __shfl_xor(v, o);
    return v;
}
#define LDS_WAIT() asm volatile("s_waitcnt lgkmcnt(0)" ::: "memory")
#define VM_WAIT() asm volatile("s_waitcnt vmcnt(0)" ::: "memory")

#define XB_TMO      128
#define XB_XCNT(j)  (256  + 64 * (j))
#define XB_XSUB(j)  (1280 + 64 * (j))
#define XB_XGEN(j)  (2304 + 64 * (j))
#define XB_TOP      3328
#define XB_TOPGEN   3392
#define XCD_BAR_WORDS 3456
#define XB_SPIN_CAP (1u << 18)
__device__ __forceinline__ unsigned xb_ld(unsigned* p)              { return __hip_atomic_load(p, __ATOMIC_RELAXED, __HIP_MEMORY_SCOPE_AGENT); }
__device__ __forceinline__ unsigned xb_add(unsigned* p, unsigned v) { return __hip_atomic_fetch_add(p, v, __ATOMIC_RELAXED, __HIP_MEMORY_SCOPE_AGENT); }
__device__ __forceinline__ unsigned xb_xcc_id() { return (unsigned)__builtin_amdgcn_s_getreg((3 << 11) | 20) & 0xFu; }
#define XB_SPIN(cond, bar) do { unsigned _sp = 0; while (cond) { __builtin_amdgcn_s_sleep(1); \
    if ((++_sp & 255u) == 0u) { if (xb_ld(&(bar)[XB_TMO])) break; if (_sp > XB_SPIN_CAP) { atomicAdd(&(bar)[XB_TMO], 1u); break; } } } } while (0)
struct XcdBarrier { unsigned* bar; unsigned x; volatile LAS unsigned* st; };
__device__ __forceinline__ XcdBarrier xcd_barrier_post(unsigned* bar, volatile LAS unsigned* st) {
    XcdBarrier b; b.bar = bar; b.x = xb_xcc_id(); b.st = st;
    if (threadIdx.x == 0) (void)xb_add(&bar[XB_XCNT(b.x)], 1u);
    return b;
}
__device__ __forceinline__ void xcd_barrier_complete(unsigned* bar, unsigned x, unsigned& nloc, unsigned& nx) {
    const unsigned G = gridDim.x * gridDim.y * gridDim.z;
    unsigned sum, cnt, mine, sp = 0u;
    for (;;) {
        sum = 0u; cnt = 0u; mine = 0u;
#pragma unroll
        for (unsigned j = 0; j < 16; ++j) { const unsigned c = xb_ld(&bar[XB_XCNT(j)]); sum += c; cnt += (c > 0u) ? 1u : 0u; mine = (j == x) ? c : mine; }
        if (sum == G) break;
        __builtin_amdgcn_s_sleep(1);
        if ((++sp & 255u) == 0u) { if (xb_ld(&bar[XB_TMO])) break; if (sp > XB_SPIN_CAP) { atomicAdd(&bar[XB_TMO], 1u); break; } }
    }
    nloc = mine > 0u ? mine : 1u; nx = cnt > 0u ? cnt : 1u;
}
__device__ __forceinline__ void xcd_barrier(const XcdBarrier& b) {
    asm volatile("s_waitcnt vmcnt(0)" ::: "memory");
    __syncthreads();
    if (threadIdx.x == 0) {
        unsigned* bar = b.bar;
        __builtin_amdgcn_s_waitcnt(0);
        unsigned nloc = b.st[0], nx = b.st[1];
        if (nloc == 0u) { xcd_barrier_complete(bar, b.x, nloc, nx); b.st[0] = nloc; b.st[1] = nx; }
        const unsigned old = xb_add(&bar[XB_XSUB(b.x)], 1u);
        const unsigned gen = old / nloc;
        if (old + 1u == (gen + 1u) * nloc) {
            __builtin_amdgcn_fence(__ATOMIC_RELEASE, "agent");
            asm volatile("s_waitcnt vmcnt(0)" ::: "memory");
            const unsigned og = xb_add(&bar[XB_TOP], 1u);
            const unsigned tg = og / nx;
            if (og + 1u == (tg + 1u) * nx) xb_add(&bar[XB_TOPGEN], 1u);
            else XB_SPIN(xb_ld(&bar[XB_TOPGEN]) == tg, bar);
            __builtin_amdgcn_fence(__ATOMIC_ACQUIRE, "agent");
            xb_add(&bar[XB_XGEN(b.x)], 1u);
            asm volatile("s_waitcnt vmcnt(0)" ::: "memory");
        } else {
            XB_SPIN(xb_ld(&bar[XB_XGEN(b.x)]) == gen, bar);
            __builtin_amdgcn_fence(__ATOMIC_ACQUIRE, "agent");
            asm volatile("s_waitcnt vmcnt(0)" ::: "memory");
        }
    }
    __syncthreads();
}

namespace pg8 {
constexpr int BM = 256, BK = 64, HALF = 128, HTB = HALF * BK * 2, STAGE_BYTES = 8 * HTB, NXCD = 8, WGM = 8;
__host__ __device__ __forceinline__ int lds_byte(int r, int c) { const int st = (r >> 4) * 2 + (c >> 5), rr = r & 15, cc = c & 31, ob = rr * 64 + cc * 2; return st * 1024 + (ob ^ (((ob >> 9) & 1) << 5)); }
__host__ __device__ __forceinline__ void stage_rc(int b, int& R, int& C) { const int st = b / 1024, sb = b % 1024, swz = sb ^ (((sb >> 9) & 1) << 5); R = (st >> 1) * 16 + swz / 64; C = (st & 1) * 32 + (swz % 64) / 2; }
__host__ __device__ __forceinline__ int perm32(int rho) { const int n = rho >> 4, i = rho & 15; return 8 * (i >> 2) + 4 * n + (i & 3); }

struct Unit { int pm, pn, kb; };
struct Gemm { const bf16_t* A; const bf16_t* Bt; int lda, ldb, K; };

template <int NK> struct Order {
    int nM, nN, nwg, G, c;
    __device__ void init(int nM_, int nN_, int G_, int c_) { nM = nM_; nN = nN_; nwg = nM * nN; G = G_; c = c_; }
    __device__ bool next(int i, Unit& u) const {
        const int it = i / NK; u.kb = i - it * NK;
        const long L = (long)it * G + c; if (L >= nwg) return false;
        int wgid = (int)L; { const int q = nwg / NXCD, r = nwg % NXCD, xcd = wgid % NXCD, off = wgid / NXCD; wgid = (xcd < r ? xcd * (q + 1) : r * (q + 1) + (xcd - r) * q) + off; }
        const int nig = WGM * nN, gid = wgid / nig, fm = gid * WGM, gsz = (nM - fm) < WGM ? (nM - fm) : WGM;
        u.pm = fm + ((wgid % nig) % gsz); u.pn = (wgid % nig) / gsz; return true;
    }
};


struct EpiSwiGLU {
    static constexpr bool PERM = true;
    bf16_t* O; const float* ssq;
    __device__ __forceinline__ void operator()(const f32x4 (&acc)[2][2][4][2], const Unit& u, int wr, int wc, int fr, int fq) const {
        const int row0 = u.pm * BM + wr * 64 + fr, col0 = u.pn * HALF + wc * 32 + 8 * fq;
#pragma unroll
        for (int ai = 0; ai < 2; ++ai)
#pragma unroll
            for (int m = 0; m < 4; ++m) {
                const int row = row0 + ai * HALF + m * 16;
                const float rs = rsqrtf(ssq[row] * (1.0f / DM) + EPS);
                float h[8];
#pragma unroll
                for (int n = 0; n < 2; ++n)
#pragma unroll
                    for (int j = 0; j < 4; ++j) { const float g = acc[ai][0][m][n][j] * rs, up = acc[ai][1][m][n][j] * rs; h[n * 4 + j] = siluf_(g) * up; }
                u32x4 w; w.x = cvt_pk_bf16(h[0], h[1]); w.y = cvt_pk_bf16(h[2], h[3]); w.z = cvt_pk_bf16(h[4], h[5]); w.w = cvt_pk_bf16(h[6], h[7]);
                *(u32x4*)(O + (size_t)row * DFF + col0) = w;
            }
    }
};
struct EpiResid {
    static constexpr bool PERM = false;
    float* X; bf16_t* XB; float* ssq_out; float scale;
    __device__ __forceinline__ void operator()(const f32x4 (&acc)[2][2][4][2], const Unit& u, int wr, int wc, int fr, int fq) const {
        const int row0 = u.pm * BM + wr * 64 + fr, col0 = u.pn * BM + wc * 32 + 4 * fq;
#pragma unroll
        for (int ai = 0; ai < 2; ++ai)
#pragma unroll
            for (int m = 0; m < 4; ++m) {
                const int row = row0 + ai * HALF + m * 16; float ss = 0.f;
                float* xp = X + (size_t)row * DM + col0; bf16_t* bp = XB + (size_t)row * DM + col0;
#pragma unroll
                for (int bj = 0; bj < 2; ++bj)
#pragma unroll
                    for (int n = 0; n < 2; ++n) {
                        const f32x4 b = *(const f32x4*)(xp + bj * HALF + n * 16);
                        const f32x4 o = b + acc[ai][bj][m][n] * scale;
                        *(f32x4*)(xp + bj * HALF + n * 16) = o;
                        ss += (o[0] * o[0] + o[1] * o[1]) + (o[2] * o[2] + o[3] * o[3]);
                        u32x2 w; w.x = cvt_pk_bf16(o[0], o[1]); w.y = cvt_pk_bf16(o[2], o[3]);
                        *(u32x2*)(bp + bj * HALF + n * 16) = w;
                    }
                ss += __shfl_xor(ss, 16); ss += __shfl_xor(ss, 32);
                if (fq == 0) atomicAdd(ssq_out + row, ss);
            }
    }
};
struct EpiProj {
    static constexpr bool PERM = true;
    bf16_t* O; const float* ssq;
    __device__ __forceinline__ void operator()(const f32x4 (&acc)[2][2][4][2], const Unit& u, int wr, int wc, int fr, int fq) const {
        const int row0 = u.pm * BM + wr * 64 + fr, col0 = u.pn * BM + wc * 32 + 8 * fq;
#pragma unroll
        for (int ai = 0; ai < 2; ++ai)
#pragma unroll
            for (int m = 0; m < 4; ++m) {
                const int row = row0 + ai * HALF + m * 16;
                const float rs = rsqrtf(ssq[row] * (1.0f / DM) + EPS);
#pragma unroll
                for (int bj = 0; bj < 2; ++bj) { const f32x4 v0 = acc[ai][bj][m][0] * rs, v1 = acc[ai][bj][m][1] * rs;
                    u32x4 w; w.x = cvt_pk_bf16(v0[0], v0[1]); w.y = cvt_pk_bf16(v0[2], v0[3]); w.z = cvt_pk_bf16(v1[0], v1[1]); w.w = cvt_pk_bf16(v1[2], v1[3]);
                    *(u32x4*)(O + (size_t)row * INP + col0 + bj * HALF) = w; }
            }
    }
};
struct EpiBranch {
    static constexpr bool PERM = true;
    const bf16_t* PROJ; float* PART; bf16_t* MRG;
    __device__ __forceinline__ void operator()(const f32x4 (&acc)[2][2][4][2], const Unit& u, int wr, int wc, int fr, int fq) const {
        const int row0 = u.pm * BM + wr * 64 + fr, col0 = u.pn * BM + wc * 32 + 8 * fq;
#pragma unroll
        for (int ai = 0; ai < 2; ++ai)
#pragma unroll
            for (int m = 0; m < 4; ++m) {
                const int row = row0 + ai * HALF + m * 16;
#pragma unroll
                for (int bj = 0; bj < 2; ++bj) {
                    const int col = col0 + bj * HALF;
                    const u32x4 gw = *(const u32x4*)(PROJ + (size_t)row * INP + PC_GATE + u.kb * DM + col);
                    float v[8];
#pragma unroll
                    for (int j = 0; j < 4; ++j) { const unsigned w = gw[j]; const float g0 = sigmoidf_(bf2f(w & 0xffffu)), g1 = sigmoidf_(bf2f(w >> 16));
                        const int e = 2 * j; v[e] = g0 * acc[ai][bj][m][e >> 2][e & 3]; v[e + 1] = g1 * acc[ai][bj][m][(e + 1) >> 2][(e + 1) & 3]; }
                    float* pp = PART + (size_t)row * DM + col;
                    if (u.kb != 0) { const f32x4 p0 = *(const f32x4*)pp, p1 = *(const f32x4*)(pp + 4);
#pragma unroll
                        for (int j = 0; j < 4; ++j) { v[j] += p0[j]; v[4 + j] += p1[j]; } }
                    if (u.kb != 2) { *(f32x4*)pp = (f32x4){v[0], v[1], v[2], v[3]}; *(f32x4*)(pp + 4) = (f32x4){v[4], v[5], v[6], v[7]}; }
                    else { u32x4 w; w.x = cvt_pk_bf16(v[0], v[1]); w.y = cvt_pk_bf16(v[2], v[3]); w.z = cvt_pk_bf16(v[4], v[5]); w.w = cvt_pk_bf16(v[6], v[7]);
                        *(u32x4*)(MRG + (size_t)row * DM + col) = w; }
                }
            }
    }
};

template <class Epi, class Sched>
__device__ __forceinline__ void gemm_phase(LAS unsigned char* lds, const Gemm g, const Sched& S, const Epi& E) {
    int tid = threadIdx.x; asm volatile("" : "+v"(tid));
    const int wid = __builtin_amdgcn_readfirstlane(tid >> 6), lane = tid & 63, wr = wid >> 2, wc = wid & 3, fr = lane & 15, fq = lane >> 4;
    const int K = g.K, nt = K / BK;
    unsigned voffA[2], voffB[2];
#pragma unroll
    for (int i = 0; i < 2; ++i) { int R, C; stage_rc(tid * 16 + i * 8192, R, C); const int Rb = Epi::PERM ? ((R & ~31) + perm32(R & 31)) : R;
        voffA[i] = (unsigned)(R * g.lda + C) * 2u; voffB[i] = (unsigned)(Rb * g.ldb + C) * 2u; }
    const size_t kstep = (size_t)(BK * 2);
    const size_t hstepA = (size_t)HALF * g.lda * 2, hstepB = (size_t)HALF * g.ldb * 2;
    const size_t tstepA = 2 * hstepA, tstepB = 2 * hstepB, kbstep = (size_t)K * 2;
    const unsigned ldsw = (unsigned)wid * 1024u;
    const int aoff = lds_byte(wr * 64 + fr, fq * 8), boff = lds_byte(wc * 32 + fr, fq * 8);
#define PG8_SA(b, h) (((b) * 2 + (h)) * HTB)
#define PG8_SB(b, h) ((4 + (b) * 2 + (h)) * HTB)
#define PG8_STAGE(bufoff, gbase, voff) do { _Pragma("unroll") for (int _i = 0; _i < 2; ++_i) \
        __builtin_amdgcn_global_load_lds((const unsigned*)((const char*)(gbase) + (voff)[_i]), (LAS unsigned*)(lds + (bufoff) + ldsw + _i * 8192), 16, 0, 0); } while (0)
#define PG8_LDA(dst, b, h) do { _Pragma("unroll") for (int m = 0; m < 4; ++m) _Pragma("unroll") for (int k = 0; k < 2; ++k) dst[m][k] = *(const LAS bf16x8*)(lds + PG8_SA(b, h) + aoff + m * 2048 + k * 1024); } while (0)
#define PG8_LDB(dst, b, h) do { _Pragma("unroll") for (int n = 0; n < 2; ++n) _Pragma("unroll") for (int k = 0; k < 2; ++k) dst[n][k] = *(const LAS bf16x8*)(lds + PG8_SB(b, h) + boff + n * 2048 + k * 1024); } while (0)
#define PG8_MMA(ai, bj, At, Bt) do { __builtin_amdgcn_s_setprio(1); _Pragma("unroll") for (int m = 0; m < 4; ++m) _Pragma("unroll") for (int n = 0; n < 2; ++n) _Pragma("unroll") for (int k = 0; k < 2; ++k) \
        acc[ai][bj][m][n] = __builtin_amdgcn_mfma_f32_16x16x32_bf16(Bt[n][k], At[m][k], acc[ai][bj][m][n], 0, 0, 0); __builtin_amdgcn_s_setprio(0); } while (0)
#define PG8_WAIT_V(n) asm volatile("s_waitcnt vmcnt(" #n ")" ::: "memory")
#define PG8_WAIT_L(n) asm volatile("s_waitcnt lgkmcnt(" #n ")" ::: "memory")
#define PG8_BAR __builtin_amdgcn_s_barrier()
#define PG8_SCHED __builtin_amdgcn_sched_barrier(0)
    Unit cur, nxt; int ui = 0;
    if (!S.next(0, cur)) return;
    f32x4 acc[2][2][4][2];
#pragma unroll
    for (int a = 0; a < 2; ++a)
#pragma unroll
        for (int b = 0; b < 2; ++b)
#pragma unroll
            for (int m = 0; m < 4; ++m)
#pragma unroll
                for (int n = 0; n < 2; ++n) acc[a][b][m][n] = (f32x4){0.f, 0.f, 0.f, 0.f};
    bf16x8 At[4][2], B0[2][2], B1[2][2];
    const char* cA = (const char*)g.A + (size_t)cur.pm * tstepA + (size_t)cur.kb * kbstep; const char* cB = (const char*)g.Bt + (size_t)cur.pn * tstepB + (size_t)cur.kb * kbstep;
    PG8_STAGE(PG8_SB(0, 0), cB, voffB); PG8_STAGE(PG8_SB(0, 1), cB + hstepB, voffB); PG8_STAGE(PG8_SA(0, 0), cA, voffA); PG8_STAGE(PG8_SA(0, 1), cA + hstepA, voffA);
    if (wr == 1) PG8_BAR;
    PG8_WAIT_V(2); PG8_BAR;
    PG8_STAGE(PG8_SB(1, 0), cB + kstep, voffB); PG8_STAGE(PG8_SA(1, 0), cA + kstep, voffA); PG8_STAGE(PG8_SB(1, 1), cB + hstepB + kstep, voffB);
    PG8_WAIT_V(6); PG8_BAR;
    for (;;) {
        const bool has_next = S.next(ui + 1, nxt);
        const char* nA = has_next ? (const char*)g.A + (size_t)nxt.pm * tstepA + (size_t)nxt.kb * kbstep : cA;
        const char* nB = has_next ? (const char*)g.Bt + (size_t)nxt.pn * tstepB + (size_t)nxt.kb * kbstep : cB;
        for (int t = 0; t < nt; t += 2) {
            const bool last = (t == nt - 2);
            const char* a1 = cA + (size_t)(t + 1) * kstep;
            const char* a2 = last ? nA : cA + (size_t)(t + 2) * kstep; const char* b2 = last ? nB : cB + (size_t)(t + 2) * kstep;
            const char* a3 = a2 + kstep; const char* b3 = b2 + kstep;
            PG8_LDB(B0, 0, 0); PG8_LDB(B1, 0, 1); PG8_SCHED; PG8_LDA(At, 0, 0); PG8_STAGE(PG8_SA(1, 1), a1 + hstepA, voffA);
            PG8_WAIT_V(8); PG8_WAIT_L(0); PG8_BAR; PG8_MMA(0, 0, At, B0); PG8_MMA(0, 1, At, B1); PG8_BAR; PG8_SCHED;
            PG8_LDA(At, 0, 1); PG8_STAGE(PG8_SB(0, 0), b2, voffB); PG8_STAGE(PG8_SB(0, 1), b2 + hstepB, voffB); PG8_STAGE(PG8_SA(0, 0), a2, voffA);
            PG8_WAIT_V(8); PG8_WAIT_L(0); PG8_BAR; PG8_MMA(1, 0, At, B0); PG8_MMA(1, 1, At, B1); PG8_BAR; PG8_SCHED;
            PG8_LDB(B0, 1, 0); PG8_LDB(B1, 1, 1); PG8_SCHED; PG8_LDA(At, 1, 0); PG8_STAGE(PG8_SA(0, 1), a2 + hstepA, voffA);
            PG8_WAIT_V(8); PG8_WAIT_L(0); PG8_BAR; PG8_MMA(0, 0, At, B0); PG8_MMA(0, 1, At, B1); PG8_BAR; PG8_SCHED;
            PG8_LDA(At, 1, 1); PG8_STAGE(PG8_SB(1, 0), b3, voffB); PG8_STAGE(PG8_SB(1, 1), b3 + hstepB, voffB); PG8_STAGE(PG8_SA(1, 0), a3, voffA);
            PG8_WAIT_V(8); PG8_WAIT_L(0); PG8_BAR; PG8_MMA(1, 0, At, B0); PG8_MMA(1, 1, At, B1); PG8_BAR; PG8_SCHED;
        }
        if (wr == 0) PG8_BAR;
        E(acc, cur, wr, wc, fr, fq);
        if (!has_next) break;
#pragma unroll
        for (int a = 0; a < 2; ++a)
#pragma unroll
            for (int b = 0; b < 2; ++b)
#pragma unroll
                for (int m = 0; m < 4; ++m)
#pragma unroll
                    for (int n = 0; n < 2; ++n) acc[a][b][m][n] = (f32x4){0.f, 0.f, 0.f, 0.f};
        cur = nxt; cA = nA; cB = nB; ++ui;
        if (wr == 1) PG8_BAR;
    }
    PG8_WAIT_V(0);
    PG8_BAR;
#undef PG8_SA
#undef PG8_SB
#undef PG8_STAGE
#undef PG8_LDA
#undef PG8_LDB
#undef PG8_MMA
#undef PG8_WAIT_V
#undef PG8_WAIT_L
#undef PG8_BAR
#undef PG8_SCHED
}
}

struct Args { const float* in[30]; float* out; unsigned char* ws; int ph_lo, ph_hi; };
enum { I_XP = 0, I_XS, I_SCONV, I_SSSM, I_SHGRN, I_SGLA, I_F1N, I_F1GU, I_F1D, I_MIXN, I_WIN, I_CONVW, I_CONVB, I_DTB, I_ALOG, I_DSKIP, I_MNORM, I_LBL, I_HNORM, I_GWD, I_GBD, I_GNORM,
       I_WBM, I_WBH, I_WBG, I_WOUT, I_F2N, I_F2GU, I_F2D, I_FINN };

__device__ __forceinline__ int map_col(int map, int np) {
    if (map == 0) return np;
    if (map == 1) { const int pn = np >> 8, w = np & 255; return w < 128 ? 128 * pn + w : DFF + 128 * pn + (w - 128); }
    if (np < 2560) return np;
    if (np < PC_GATE) return np + 16;
    if (np < PC_DT) return np + 32;
    if (np < PC_GA) return 2560 + (np - PC_DT);
    if (np < INC) return 9744 + (np - PC_GA);
    return -1;
}
struct TrItem { const float* W; const float* kscale; bf16_t* WT; int N, ldk, koff, map, k0, n0; };
__device__ __forceinline__ void tr_load(const TrItem& T, int tid, f32x4 (&v)[8]) {
    const int c4 = (tid & 31) * 4, src = map_col(T.map, T.n0 + c4);
#pragma unroll
    for (int i = 0; i < 8; ++i) { const int r = (tid >> 5) + 16 * i; v[i] = (f32x4){0.f, 0.f, 0.f, 0.f};
        if (src >= 0) { v[i] = *(const f32x4*)(T.W + (size_t)(T.k0 + r) * T.N + src); if (T.kscale) v[i] = v[i] * T.kscale[T.k0 + r]; } }
}
__device__ __forceinline__ void tr_store(const TrItem& T, int tid, const f32x4 (&v)[8], LAS float* tile) {
    const int c4 = (tid & 31) * 4;
#pragma unroll
    for (int i = 0; i < 8; ++i) { const int r = (tid >> 5) + 16 * i; LAS float* p = tile + r * 129 + c4; p[0] = v[i][0]; p[1] = v[i][1]; p[2] = v[i][2]; p[3] = v[i][3]; }
    LDS_WAIT(); __syncthreads();
    const int kg = tid & 15;
#pragma unroll
    for (int j = 0; j < 4; ++j) { const int n = (tid >> 4) + 32 * j; const LAS float* sp = tile + (8 * kg) * 129 + n;
        u32x4 o; o.x = cvt_pk_bf16(sp[0], sp[129]); o.y = cvt_pk_bf16(sp[2 * 129], sp[3 * 129]); o.z = cvt_pk_bf16(sp[4 * 129], sp[5 * 129]); o.w = cvt_pk_bf16(sp[6 * 129], sp[7 * 129]);
        *(u32x4*)(T.WT + (size_t)(T.n0 + n) * T.ldk + T.koff + T.k0 + 8 * kg) = o; }
    LDS_WAIT(); __syncthreads();
}
__device__ __forceinline__ TrItem tr_item(const Args& a, int it) {
    constexpr int IT_GU = 16 * 88, IT_D = 44 * 16, IT_IN = 16 * 126, IT_B = 8 * 16, IT_O = 16 * 16;
    constexpr int IT_LAYER = 2 * IT_GU + 2 * IT_D + IT_IN + 3 * IT_B + IT_O;
    const int l = it / IT_LAYER; int r = it - l * IT_LAYER;
    unsigned char* wl = a.ws + WS_W + (size_t)l * WL_STRIDE;
    TrItem T; int nblk;
    if (r < IT_GU) { T = TrItem{a.in[I_F1GU] + (size_t)l * DM * 2 * DFF, a.in[I_F1N] + l * DM, (bf16_t*)(wl + WL_GU1), 2 * DFF, DM, 0, 1, 0, 0}; nblk = 88; }
    else if ((r -= IT_GU) < IT_D) { T = TrItem{a.in[I_F1D] + (size_t)l * DFF * DM, nullptr, (bf16_t*)(wl + WL_D1), DM, DFF, 0, 0, 0, 0}; nblk = 16; }
    else if ((r -= IT_D) < IT_IN) { T = TrItem{a.in[I_WIN] + (size_t)l * DM * INC, a.in[I_MIXN] + l * DM, (bf16_t*)(wl + WL_IN), INC, DM, 0, 2, 0, 0}; nblk = 126; }
    else if ((r -= IT_IN) < IT_B) { T = TrItem{a.in[I_WBM] + (size_t)l * 1024 * DM, nullptr, (bf16_t*)(wl + WL_BR), DM, 3072, 0, 0, 0, 0}; nblk = 16; }
    else if ((r -= IT_B) < IT_B) { T = TrItem{a.in[I_WBH] + (size_t)l * 1024 * DM, nullptr, (bf16_t*)(wl + WL_BR), DM, 3072, 1024, 0, 0, 0}; nblk = 16; }
    else if ((r -= IT_B) < IT_B) { T = TrItem{a.in[I_WBG] + (size_t)l * 1024 * DM, nullptr, (bf16_t*)(wl + WL_BR), DM, 3072, 2048, 0, 0, 0}; nblk = 16; }
    else if ((r -= IT_B) < IT_O) { T = TrItem{a.in[I_WOUT] + (size_t)l * DM * DM, nullptr, (bf16_t*)(wl + WL_OUT), DM, DM, 0, 0, 0, 0}; nblk = 16; }
    else if ((r -= IT_O) < IT_GU) { T = TrItem{a.in[I_F2GU] + (size_t)l * DM * 2 * DFF, a.in[I_F2N] + l * DM, (bf16_t*)(wl + WL_GU2), 2 * DFF, DM, 0, 1, 0, 0}; nblk = 88; }
    else { r -= IT_GU; T = TrItem{a.in[I_F2D] + (size_t)l * DFF * DM, nullptr, (bf16_t*)(wl + WL_D2), DM, DFF, 0, 0, 0, 0}; nblk = 16; }
    T.k0 = 128 * (r / nblk); T.n0 = 128 * (r % nblk);
    return T;
}
constexpr int TR_ITEMS = DEPTH * (2 * 16 * 88 + 2 * 44 * 16 + 16 * 126 + 3 * 8 * 16 + 16 * 16);

struct Ctx {
    LAS unsigned char* lds; const Args* a; unsigned char* ws; int tid, lane, wave, G, gw, NGW;
};

__device__ __forceinline__ void phase_prologue(const Args& a, LAS unsigned char* lds) {
    int tid = threadIdx.x; asm volatile("" : "+v"(tid));
    const int lane = tid & 63, wave = __builtin_amdgcn_readfirstlane(tid >> 6), gw = blockIdx.x * 8 + wave, NGW = gridDim.x * 8;
    unsigned char* ws = a.ws;
    { LAS float* tile = (LAS float*)lds; const int G = gridDim.x;
      int it = blockIdx.x; f32x4 v[8];
      if (it < TR_ITEMS) { const TrItem T = tr_item(a, it); tr_load(T, tid, v); }
      while (it < TR_ITEMS) {
          const TrItem T = tr_item(a, it); f32x4 cur[8];
#pragma unroll
          for (int i = 0; i < 8; ++i) cur[i] = v[i];
          const int nx = it + G;
          if (nx < TR_ITEMS) { const TrItem Tn = tr_item(a, nx); tr_load(Tn, tid, v); }
          tr_store(T, tid, cur, tile);
          it = nx;
      } }
    float* X = (float*)(ws + WS_X); bf16_t* XB = (bf16_t*)(ws + WS_XB); float* ssq0 = (float*)(ws + WS_CTL + CTL_SSQ);
    for (int r = gw; r < MP; r += NGW) {
        const float* src = r < NPROMPT ? a.in[I_XP] + (size_t)r * DM : (r < NTOK ? a.in[I_XS] + (size_t)(r - NPROMPT) * DM : nullptr);
        float ss = 0.f;
#pragma unroll
        for (int j = 0; j < 8; ++j) { f32x4 v = (f32x4){0.f, 0.f, 0.f, 0.f}; if (src) v = *(const f32x4*)(src + 4 * lane + 256 * j);
            *(f32x4*)(X + (size_t)r * DM + 4 * lane + 256 * j) = v; ss += (v[0] * v[0] + v[1] * v[1]) + (v[2] * v[2] + v[3] * v[3]);
            u32x2 w; w.x = cvt_pk_bf16(v[0], v[1]); w.y = cvt_pk_bf16(v[2], v[3]); *(u32x2*)(XB + (size_t)r * DM + 4 * lane + 256 * j) = w; }
        ss = wave_sum(ss); if (lane == 0) ssq0[r] = ss;
        if (r >= NTOK) { bf16_t* y = (bf16_t*)(ws + WS_Y) + (size_t)r * 3072;
#pragma unroll
            for (int j = 0; j < 6; ++j) *(u32x4*)(y + 8 * lane + 512 * j) = (u32x4){0u, 0u, 0u, 0u}; }
    }
    float* LB = (float*)(ws + WS_LB);
    for (int c = gw * 64 + lane; c < 1024; c += NGW * 64) {
        float mx = -1e30f; for (int l = 0; l < DEPTH; ++l) mx = fmaxf(mx, a.in[I_LBL][l * 1024 + c]);
        float den = 0.f; for (int l = 0; l < DEPTH; ++l) den += expf(a.in[I_LBL][l * 1024 + c] - mx);
        float cum = 0.f; const float sm0 = expf(a.in[I_LBL][c] - mx) / den;
        for (int l = 0; l < DEPTH; ++l) { cum += expf(a.in[I_LBL][l * 1024 + c] - mx) / den; LB[l * 1024 + c] = cum - sm0; }
    }
}

__device__ __forceinline__ void unpack8(const u32x4 w, float (&x)[8]) {
#pragma unroll
    for (int j = 0; j < 4; ++j) { x[2 * j] = bf2f(w[j] & 0xffffu); x[2 * j + 1] = bf2f(w[j] >> 16); }
}
__device__ __forceinline__ void phase_prep(const Args& a, int l, LAS unsigned char* lds) {
    int tid = threadIdx.x; asm volatile("" : "+v"(tid));
    const int lane = tid & 63, wave = __builtin_amdgcn_readfirstlane(tid >> 6), gw = blockIdx.x * 8 + wave, NGW = gridDim.x * 8;
    unsigned char* ws = a.ws;
    const bf16_t* PROJ = (const bf16_t*)(ws + WS_PROJ); bf16_t* XC = (bf16_t*)(ws + WS_XC); float* DT = (float*)(ws + WS_DT); float* LGA = (float*)(ws + WS_LGA);
    LAS float* swd = (LAS float*)lds;
    for (int i = tid; i < 16 * 512; i += 512) swd[i] = a.in[I_GWD][(size_t)l * 16 * 512 + i];
    for (int i = tid; i < 512; i += 512) swd[8192 + i] = a.in[I_GBD][l * 512 + i];
    __syncthreads();
    const float* cw = a.in[I_CONVW] + (size_t)l * 4 * 1536; const float* cb = a.in[I_CONVB] + l * 1536;
    for (int r = gw; r < NTOK; r += NGW) {
        const bool samp = r >= NPROMPT; const int t = samp ? 0 : (r & (SEQ - 1)), s = r - NPROMPT, b = r >> 11;
        const bf16_t* prow = PROJ + (size_t)r * INP;
#pragma unroll 1
        for (int i = 0; i < 3; ++i) {
            const int ch = lane * 8 + 512 * i;
            float c[8], x[8];
            { const f32x4 b0 = *(const f32x4*)(cb + ch), b1 = *(const f32x4*)(cb + ch + 4);
#pragma unroll
              for (int j = 0; j < 4; ++j) { c[j] = b0[j]; c[4 + j] = b1[j]; } }
            unpack8(*(const u32x4*)(prow + PC_XBC + ch), x);
            { const f32x4 w0 = *(const f32x4*)(cw + 3 * 1536 + ch), w1 = *(const f32x4*)(cw + 3 * 1536 + ch + 4);
#pragma unroll
              for (int j = 0; j < 4; ++j) { c[j] += w0[j] * x[j]; c[4 + j] += w1[j] * x[4 + j]; } }
            if (samp) { float* op = a.out + O_CS + (((size_t)l * NSAMP + s) * 3 + 2) * 1536 + ch; *(f32x4*)op = (f32x4){x[0], x[1], x[2], x[3]}; *(f32x4*)(op + 4) = (f32x4){x[4], x[5], x[6], x[7]}; }
            else if (t >= SEQ - 3) { float* op = a.out + O_CP + (((size_t)l * NB + b) * 3 + (t - (SEQ - 3))) * 1536 + ch; *(f32x4*)op = (f32x4){x[0], x[1], x[2], x[3]}; *(f32x4*)(op + 4) = (f32x4){x[4], x[5], x[6], x[7]}; }
#pragma unroll
            for (int k = 1; k <= 3; ++k) {
                if (samp) { const float* sp = a.in[I_SCONV] + (((size_t)l * NSAMP + s) * 3 + (3 - k)) * 1536 + ch; const f32x4 p0 = *(const f32x4*)sp, p1 = *(const f32x4*)(sp + 4);
#pragma unroll
                    for (int j = 0; j < 4; ++j) { x[j] = p0[j]; x[4 + j] = p1[j]; }
                    if (k <= 2) { float* op = a.out + O_CS + (((size_t)l * NSAMP + s) * 3 + (2 - k)) * 1536 + ch; *(f32x4*)op = p0; *(f32x4*)(op + 4) = p1; } }
                else if (t - k >= 0) unpack8(*(const u32x4*)(prow - (size_t)k * INP + PC_XBC + ch), x);
                else {
#pragma unroll
                    for (int j = 0; j < 8; ++j) x[j] = 0.f; }
                const f32x4 w0 = *(const f32x4*)(cw + (3 - k) * 1536 + ch), w1 = *(const f32x4*)(cw + (3 - k) * 1536 + ch + 4);
#pragma unroll
                for (int j = 0; j < 4; ++j) { c[j] += w0[j] * x[j]; c[4 + j] += w1[j] * x[4 + j]; }
            }
            u32x4 w; w.x = cvt_pk_bf16(siluf_(c[0]), siluf_(c[1])); w.y = cvt_pk_bf16(siluf_(c[2]), siluf_(c[3])); w.z = cvt_pk_bf16(siluf_(c[4]), siluf_(c[5])); w.w = cvt_pk_bf16(siluf_(c[6]), siluf_(c[7]));
            *(u32x4*)(XC + (size_t)r * 1536 + ch) = w;
        }
        if (lane < 16) DT[(size_t)r * 16 + lane] = softplusf_(bf2f(prow[PC_DT + lane]) + a.in[I_DTB][l * 16 + lane]);
        { float ga[16];
          unpack8(*(const u32x4*)(prow + PC_GA), *(float(*)[8])&ga[0]); unpack8(*(const u32x4*)(prow + PC_GA + 8), *(float(*)[8])&ga[8]);
          float pre[8];
#pragma unroll
          for (int e = 0; e < 8; ++e) pre[e] = swd[8192 + lane * 8 + e];
#pragma unroll
          for (int i = 0; i < 16; ++i)
#pragma unroll
              for (int e = 0; e < 8; ++e) pre[e] += ga[i] * swd[i * 512 + lane * 8 + e];
          float lo[8];
#pragma unroll
          for (int e = 0; e < 8; ++e) lo[e] = -(fmaxf(-pre[e], 0.f) + log1pf(__expf(-fabsf(pre[e])))) * (1.0f / 16.0f);
          float* op = LGA + (size_t)r * 512 + lane * 8;
          *(f32x4*)op = (f32x4){lo[0], lo[1], lo[2], lo[3]}; *(f32x4*)(op + 4) = (f32x4){lo[4], lo[5], lo[6], lo[7]}; }
    }
}

constexpr int CS_QD = 0, CS_KD = 17408, CS_QE = 34816, CS_KET = 52224, CS_VT = 70656, CS_ST = 79872, CS_P = 97280, CS_TOT = 106496, CS_EGL = 108544, CS_GS = 109056, CS_END = 109312;
constexpr int SMP_LDS = 114688;
#define CFRAG(base, RS, rowblk, ks) (*(const LAS bf16x8*)(lds + (base) + ((rowblk) * 16 + fr) * (RS) + ((ks) * 32 + fq * 8) * 2))
template <int MIX>
__device__ __forceinline__ void chunk_unit(const Args& a, int l, int b, int h, int j0, LAS unsigned char* lds, const int tid) {
    unsigned char* ws = a.ws;
    const int lane = tid & 63, wave = __builtin_amdgcn_readfirstlane(tid >> 6), d = tid & 127, tq = tid >> 7, fr = lane & 15, fq = lane >> 4;
    const bf16_t* src = (MIX == 0) ? (const bf16_t*)(ws + WS_XC) : (const bf16_t*)(ws + WS_PROJ);
    constexpr int SS = (MIX == 0) ? 1536 : INP;
    const int qcol = (MIX == 0) ? 1280 + (h >> 3) * 128 : (MIX == 1 ? PC_HQ + h * 128 : PC_GQ + h * 128);
    const int kcol = (MIX == 0) ? 1024 + (h >> 3) * 128 : (MIX == 1 ? PC_HF + h * 128 : PC_GK + h * 128);
    const int vcol = (MIX == 0) ? h * 64 : (MIX == 1 ? PC_HI + h * 128 + j0 : PC_GV + h * 256 + j0);
    const int ocol = (MIX == 0) ? h * 64 : (MIX == 1 ? 1024 + h * 128 + j0 : 2048 + h * 256 + j0);
    const float* DT = (const float*)(ws + WS_DT); const float* LGA = (const float*)(ws + WS_LGA); float* O = (float*)(ws + WS_O);
    const float aH = (MIX == 0) ? -__expf(a.in[I_ALOG][l * 16 + h]) : 0.f;
    const float lb = (MIX == 1) ? ((const float*)(ws + WS_LB))[l * 1024 + h * 128 + d] : 0.f;
    const float dskip = (MIX == 0) ? a.in[I_DSKIP][l * 16 + h] : 0.f;
    constexpr float QS = 0.08838834764831845f;
    LAS float* tot = (LAS float*)(lds + CS_TOT); LAS float* eGl = (LAS float*)(lds + CS_EGL); LAS float* Gs = (LAS float*)(lds + CS_GS);
    f32x4 S[4];
#pragma unroll
    for (int i = 0; i < 4; ++i) S[i] = (f32x4){0.f, 0.f, 0.f, 0.f};
    __syncthreads();
    for (int i = tid; i < 17408 / 4; i += 512) ((LAS unsigned*)(lds + CS_ST))[i] = 0u;
    unsigned rq[16], rk[16]; float rg[16]; u32x4 rv; float rdt = 0.f;
    const int vs = tid >> 3, v8 = (tid & 7) * 8;
#define CLOAD(c) do { const size_t rb_ = (size_t)b * SEQ + (size_t)(c) * 64; \
    _Pragma("unroll") for (int i = 0; i < 16; ++i) { const size_t r = rb_ + 16 * tq + i; rq[i] = src[r * SS + qcol + d]; rk[i] = src[r * SS + kcol + d]; \
        rg[i] = (MIX == 0) ? DT[r * 16 + h] : ((MIX == 2) ? LGA[r * 512 + h * 128 + d] : 0.f); } \
    rv = *(const u32x4*)(src + (rb_ + vs) * SS + vcol + v8); if (MIX == 0) rdt = DT[(rb_ + vs) * 16 + h]; } while (0)
    CLOAD(0);
    for (int c = 0; c < SEQ / 64; ++c) {
        const size_t rb = (size_t)b * SEQ + (size_t)c * 64;
        float g[16], kv[16], qv[16];
#pragma unroll
        for (int i = 0; i < 16; ++i) { const float q0 = bf2f(rq[i]), k0 = bf2f(rk[i]);
            if (MIX == 0) { qv[i] = q0; kv[i] = k0; g[i] = rg[i] * aH; }
            else if (MIX == 1) { qv[i] = siluf_(q0) * QS; const float sg = sigmoidf_(k0); const float f = lb + (1.f - lb) * sg; g[i] = __logf(fmaxf(f, 1.17549435e-38f)); kv[i] = (1.f - lb) * fast_rcp(1.f + __expf(k0)); }
            else { qv[i] = q0 * QS; kv[i] = k0; g[i] = rg[i]; } }
#pragma unroll
        for (int i = 1; i < 16; ++i) g[i] += g[i - 1];
        tot[tq * 128 + d] = g[15];
        float xv[8];
#pragma unroll
        for (int j = 0; j < 4; ++j) { xv[2 * j] = bf2f(rv[j] & 0xffffu); xv[2 * j + 1] = bf2f(rv[j] >> 16); }
        if (MIX == 0) {
#pragma unroll
            for (int j = 0; j < 8; ++j) xv[j] *= rdt; }
#pragma unroll
        for (int e = 0; e < 8; ++e) *(LAS unsigned short*)(lds + CS_VT + (v8 + e) * 144 + vs * 2) = (unsigned short)f2bf(xv[e]);
        LDS_WAIT(); __syncthreads();
        const float t0 = tot[d], t1 = tot[128 + d], t2 = tot[256 + d], t3 = tot[384 + d];
        const float prefix = tq == 0 ? 0.f : (tq == 1 ? t0 : (tq == 2 ? t0 + t1 : t0 + t1 + t2)), Gref = t0 + t1, Glast = (t0 + t1) + (t2 + t3);
        unsigned kep[8];
#pragma unroll
        for (int i = 0; i < 16; ++i) { const float G = prefix + g[i]; const int t = 16 * tq + i;
            float qd, kd;
            if (MIX == 0) { qd = qv[i]; kd = kv[i]; } else { qd = qv[i] * __expf(fminf(G - Gref, 80.f)); kd = kv[i] * __expf(fminf(Gref - G, 80.f)); }
            const float qe = qv[i] * __expf(G), ke = kv[i] * __expf(Glast - G);
            *(LAS unsigned short*)(lds + CS_QD + t * 272 + d * 2) = (unsigned short)f2bf(qd);
            *(LAS unsigned short*)(lds + CS_KD + t * 272 + d * 2) = (unsigned short)f2bf(kd);
            *(LAS unsigned short*)(lds + CS_QE + t * 272 + d * 2) = (unsigned short)f2bf(qe);
            if (i & 1) kep[i >> 1] |= f2bf(ke) << 16; else kep[i >> 1] = f2bf(ke);
            if (MIX == 0 && d == 0) Gs[t] = G; }
        *(LAS u32x4*)(lds + CS_KET + d * 144 + tq * 32) = (u32x4){kep[0], kep[1], kep[2], kep[3]};
        *(LAS u32x4*)(lds + CS_KET + d * 144 + tq * 32 + 16) = (u32x4){kep[4], kep[5], kep[6], kep[7]};
        if (tq == 0) eGl[d] = __expf(Glast);
        if (c + 1 < SEQ / 64) CLOAD(c + 1);
        LDS_WAIT(); __syncthreads();
        const int tb = wave >> 1, half = wave & 1;
        f32x4 ao[2];
        { bf16x8 qe[4];
#pragma unroll
          for (int ks = 0; ks < 4; ++ks) qe[ks] = CFRAG(CS_QE, 272, tb, ks);
#pragma unroll
          for (int vv = 0; vv < 2; ++vv) { ao[vv] = (f32x4){0.f, 0.f, 0.f, 0.f};
#pragma unroll
              for (int ks = 0; ks < 4; ++ks) ao[vv] = __builtin_amdgcn_mfma_f32_16x16x32_bf16(CFRAG(CS_ST, 272, 2 * half + vv, ks), qe[ks], ao[vv], 0, 0, 0); } }
        { bf16x8 qd[4];
#pragma unroll
          for (int ks = 0; ks < 4; ++ks) qd[ks] = CFRAG(CS_QD, 272, tb, ks);
          const int t = 16 * tb + fr;
#pragma unroll
          for (int ss = 0; ss < 2; ++ss) { const int sb = 2 * half + ss; f32x4 aa = (f32x4){0.f, 0.f, 0.f, 0.f};
              if (sb <= tb) {
#pragma unroll
                  for (int ks = 0; ks < 4; ++ks) aa = __builtin_amdgcn_mfma_f32_16x16x32_bf16(CFRAG(CS_KD, 272, sb, ks), qd[ks], aa, 0, 0, 0);
#pragma unroll
                  for (int rg_ = 0; rg_ < 4; ++rg_) { const int sidx = 16 * sb + 4 * fq + rg_; const bool keep = sidx <= t;
                      float vA = aa[rg_]; if (MIX == 0) vA *= __expf(keep ? Gs[t] - Gs[sidx] : 0.f); aa[rg_] = keep ? vA : 0.f; } }
              u32x2 pw; pw.x = cvt_pk_bf16(aa[0], aa[1]); pw.y = cvt_pk_bf16(aa[2], aa[3]);
              *(LAS u32x2*)(lds + CS_P + t * 144 + (16 * sb + 4 * fq) * 2) = pw; } }
        LDS_WAIT(); __syncthreads();
        { bf16x8 p[2];
#pragma unroll
          for (int ks = 0; ks < 2; ++ks) p[ks] = CFRAG(CS_P, 144, tb, ks);
#pragma unroll
          for (int vv = 0; vv < 2; ++vv)
#pragma unroll
              for (int ks = 0; ks < 2; ++ks) ao[vv] = __builtin_amdgcn_mfma_f32_16x16x32_bf16(CFRAG(CS_VT, 144, 2 * half + vv, ks), p[ks], ao[vv], 0, 0, 0); }
        { const size_t r = rb + 16 * tb + fr;
#pragma unroll
          for (int vv = 0; vv < 2; ++vv) { const int v0 = 16 * (2 * half + vv) + 4 * fq; f32x4 o = ao[vv];
              if (MIX == 0) { const u32x2 xw = *(const u32x2*)(src + r * SS + vcol + v0); o[0] += dskip * bf2f(xw.x & 0xffffu); o[1] += dskip * bf2f(xw.x >> 16); o[2] += dskip * bf2f(xw.y & 0xffffu); o[3] += dskip * bf2f(xw.y >> 16); }
              *(f32x4*)(O + r * 3072 + ocol + v0) = o; } }
        { bf16x8 ke[2];
#pragma unroll
          for (int ks = 0; ks < 2; ++ks) ke[ks] = CFRAG(CS_KET, 144, wave, ks);
          const f32x4 ev = *(const LAS f32x4*)(eGl + 16 * wave + 4 * fq);
#pragma unroll
          for (int vb = 0; vb < 4; ++vb) { S[vb] = S[vb] * ev;
#pragma unroll
              for (int ks = 0; ks < 2; ++ks) S[vb] = __builtin_amdgcn_mfma_f32_16x16x32_bf16(ke[ks], CFRAG(CS_VT, 144, vb, ks), S[vb], 0, 0, 0);
              u32x2 sw; sw.x = cvt_pk_bf16(S[vb][0], S[vb][1]); sw.y = cvt_pk_bf16(S[vb][2], S[vb][3]);
              *(LAS u32x2*)(lds + CS_ST + (16 * vb + fr) * 272 + (16 * wave + 4 * fq) * 2) = sw; } }
        LDS_WAIT(); __syncthreads();
    }
#undef CLOAD
#pragma unroll
    for (int vb = 0; vb < 4; ++vb) { const int v = 16 * vb + fr, d0 = 16 * wave + 4 * fq;
        if (MIX == 0) { float* sp = a.out + O_SP + ((((size_t)l * NB + b) * 16 + h) * 64 + v) * 128 + d0; *(f32x4*)sp = S[vb]; }
        else if (MIX == 1) { float* sp = a.out + O_HP + (((size_t)l * NB + b) * 8 + h) * 16384 + (size_t)d0 * 128 + j0 + v;
#pragma unroll
            for (int rg_ = 0; rg_ < 4; ++rg_) sp[rg_ * 128] = S[vb][rg_]; }
        else { float* sp = a.out + O_GP + (((size_t)l * NB + b) * 4 + h) * 32768 + (size_t)d0 * 256 + j0 + v;
#pragma unroll
            for (int rg_ = 0; rg_ < 4; ++rg_) sp[rg_ * 256] = S[vb][rg_]; } }
}
#undef CFRAG

__device__ __forceinline__ void sample_unit_wave(const Args& a, int l, int su, LAS float* wl, const int lane) {
    unsigned char* ws = a.ws;
    const int mix = su >> 11, rem = su & 2047, s = rem >> 4, hs = rem & 15;
    const size_t r = (size_t)NPROMPT + s;
    const bf16_t* PROJ = (const bf16_t*)(ws + WS_PROJ) + r * INP; const bf16_t* XC = (const bf16_t*)(ws + WS_XC) + r * 1536; const float* DT = (const float*)(ws + WS_DT) + r * 16; const float* LGA = (const float*)(ws + WS_LGA) + r * 512;
    float* O = (float*)(ws + WS_O) + r * 3072;
    LAS float* wq = wl; LAS float* wk = wl + 128; LAS float* wd = wl + 256;
    constexpr float QS = 0.08838834764831845f;
    float v, xs = 0.f, dskip = 0.f; int ocol;
    if (mix == 0) { const int h = hs; const float dt = DT[h], dec = __expf(dt * -__expf(a.in[I_ALOG][l * 16 + h])); dskip = a.in[I_DSKIP][l * 16 + h];
#pragma unroll
        for (int e = 0; e < 2; ++e) { const int d = lane + 64 * e; wq[d] = bf2f(XC[1280 + (h >> 3) * 128 + d]); wk[d] = bf2f(XC[1024 + (h >> 3) * 128 + d]); wd[d] = dec; }
        xs = bf2f(XC[h * 64 + lane]); v = dt * xs; ocol = h * 64; }
    else if (mix == 1) { const int h = hs >> 1, j0 = 64 * (hs & 1); const float* LB = (const float*)(ws + WS_LB) + l * 1024 + h * 128;
#pragma unroll
        for (int e = 0; e < 2; ++e) { const int d = lane + 64 * e; const float zf = bf2f(PROJ[PC_HF + h * 128 + d]), lbv = LB[d];
            wq[d] = siluf_(bf2f(PROJ[PC_HQ + h * 128 + d])) * QS; wd[d] = lbv + (1.f - lbv) * sigmoidf_(zf); wk[d] = (1.f - lbv) * fast_rcp(1.f + __expf(zf)); }
        v = bf2f(PROJ[PC_HI + h * 128 + j0 + lane]); ocol = 1024 + h * 128 + j0; }
    else { const int h = hs >> 2, j0 = 64 * (hs & 3);
#pragma unroll
        for (int e = 0; e < 2; ++e) { const int d = lane + 64 * e; wq[d] = bf2f(PROJ[PC_GQ + h * 128 + d]) * QS; wk[d] = bf2f(PROJ[PC_GK + h * 128 + d]); wd[d] = __expf(LGA[h * 128 + d]); }
        v = bf2f(PROJ[PC_GV + h * 256 + j0 + lane]); ocol = 2048 + h * 256 + j0; }
    LDS_WAIT(); asm volatile("" ::: "memory");
    float acc = 0.f;
    if (mix == 0) { const size_t sb = ((((size_t)l * NSAMP + s) * 16 + hs) * 64 + lane) * 128; const float* sin = a.in[I_SSSM] + sb; float* sout = a.out + O_SS + sb;
#pragma unroll 1
        for (int blk = 0; blk < 4; ++blk) { f32x4 st[8];
#pragma unroll
            for (int i = 0; i < 8; ++i) st[i] = *(const f32x4*)(sin + blk * 32 + 4 * i);
#pragma unroll
            for (int i = 0; i < 8; ++i) { const f32x4 qq = *(const LAS f32x4*)(wq + blk * 32 + 4 * i), kk = *(const LAS f32x4*)(wk + blk * 32 + 4 * i), dd = *(const LAS f32x4*)(wd + blk * 32 + 4 * i);
                f32x4 n = dd * st[i] + kk * v; acc += (qq[0] * n[0] + qq[1] * n[1]) + (qq[2] * n[2] + qq[3] * n[3]); *(f32x4*)(sout + blk * 32 + 4 * i) = n; } } }
    else { const int h = mix == 1 ? hs >> 1 : hs >> 2, j0 = mix == 1 ? 64 * (hs & 1) : 64 * (hs & 3), ld = mix == 1 ? 128 : 256;
        const size_t sb = (mix == 1 ? (((size_t)l * NSAMP + s) * 8 + h) * 16384 : (((size_t)l * NSAMP + s) * 4 + h) * 32768) + j0 + lane;
        const float* sin = (mix == 1 ? a.in[I_SHGRN] : a.in[I_SGLA]) + sb; float* sout = a.out + (mix == 1 ? O_HS : O_GS) + sb;
#pragma unroll 1
        for (int blk = 0; blk < 8; ++blk) { float st[16];
#pragma unroll
            for (int i = 0; i < 16; ++i) st[i] = sin[(size_t)(blk * 16 + i) * ld];
#pragma unroll
            for (int i4 = 0; i4 < 4; ++i4) { const f32x4 qq = *(const LAS f32x4*)(wq + blk * 16 + 4 * i4), kk = *(const LAS f32x4*)(wk + blk * 16 + 4 * i4), dd = *(const LAS f32x4*)(wd + blk * 16 + 4 * i4);
#pragma unroll
                for (int e = 0; e < 4; ++e) { const float n = dd[e] * st[4 * i4 + e] + kk[e] * v; acc += qq[e] * n; sout[(size_t)(blk * 16 + 4 * i4 + e) * ld] = n; } } } }
    O[ocol + lane] = acc + dskip * xs;
    LDS_WAIT(); asm volatile("" ::: "memory");
}
constexpr int CW_SQ = 2048;
__device__ __forceinline__ void phase_scan(const Args& a, int l, LAS unsigned char* lds) {
    int tid = threadIdx.x; asm volatile("" : "+v"(tid));
    const int lane = tid & 63, wave = __builtin_amdgcn_readfirstlane(tid >> 6);
    const int w = blockIdx.x;
    if (w < 192) { const int mix = w / 64, rem = w % 64, b = rem / 16, hs = rem % 16;
        if (mix == 0) chunk_unit<0>(a, l, b, hs, 0, lds, tid);
        else if (mix == 1) chunk_unit<1>(a, l, b, hs >> 1, 64 * (hs & 1), lds, tid);
        else chunk_unit<2>(a, l, b, hs >> 2, 64 * (hs & 3), lds, tid);
    }
    unsigned* head = (unsigned*)(a.ws + WS_CTL) + CW_SQ + 64 * l;
    LAS float* wl = (LAS float*)(lds + SMP_LDS + wave * 2048);
    for (;;) { unsigned su = 0; if (lane == 0) su = __hip_atomic_fetch_add(head, 1u, __ATOMIC_RELAXED, __HIP_MEMORY_SCOPE_AGENT);
        su = __builtin_amdgcn_readfirstlane(su); if (su >= 6144u) break;
        sample_unit_wave(a, l, (int)su, wl, lane); }
}

__device__ __forceinline__ void phase_post(const Args& a, int l) {
    int tid = threadIdx.x; asm volatile("" : "+v"(tid));
    const int lane = tid & 63, wave = __builtin_amdgcn_readfirstlane(tid >> 6), gw = blockIdx.x * 8 + wave, NGW = gridDim.x * 8;
    unsigned char* ws = a.ws;
    const bf16_t* PROJ = (const bf16_t*)(ws + WS_PROJ); const float* O = (const float*)(ws + WS_O); bf16_t* Y = (bf16_t*)(ws + WS_Y);
    const float* mnw = a.in[I_MNORM] + l * 1024; const float* hnw = a.in[I_HNORM] + l * 128; const float* gnw = a.in[I_GNORM] + l * 256;
    for (int r = gw; r < NTOK; r += NGW) {
        const float* orow = O + (size_t)r * 3072; const bf16_t* prow = PROJ + (size_t)r * INP; bf16_t* yrow = Y + (size_t)r * 3072;
#pragma unroll
        for (int g = 0; g < 2; ++g) { const int c0 = g * 512 + lane * 8; float y[8]; float ss = 0.f;
            const f32x4 o0 = *(const f32x4*)(orow + c0), o1 = *(const f32x4*)(orow + c0 + 4); const u32x4 zw = *(const u32x4*)(prow + PC_Z + c0);
#pragma unroll
            for (int j = 0; j < 4; ++j) { y[2 * j] = (j < 2 ? o0[2 * j] : o1[2 * j - 4]) * siluf_(bf2f(zw[j] & 0xffffu)); y[2 * j + 1] = (j < 2 ? o0[2 * j + 1] : o1[2 * j - 3]) * siluf_(bf2f(zw[j] >> 16)); }
#pragma unroll
            for (int j = 0; j < 8; ++j) ss += y[j] * y[j];
            ss = wave_sum(ss); const float rs = rsqrtf(ss * (1.0f / 512.0f) + EPS);
            u32x4 w; w.x = cvt_pk_bf16(y[0] * rs * mnw[c0], y[1] * rs * mnw[c0 + 1]); w.y = cvt_pk_bf16(y[2] * rs * mnw[c0 + 2], y[3] * rs * mnw[c0 + 3]); w.z = cvt_pk_bf16(y[4] * rs * mnw[c0 + 4], y[5] * rs * mnw[c0 + 5]); w.w = cvt_pk_bf16(y[6] * rs * mnw[c0 + 6], y[7] * rs * mnw[c0 + 7]);
            *(u32x4*)(yrow + c0) = w; }
#pragma unroll
        for (int hh = 0; hh < 8; ++hh) { const int c0 = hh * 128 + lane * 2; const f32x2 o = *(const f32x2*)(orow + 1024 + c0); const unsigned gwv = *(const unsigned*)(prow + PC_HG + c0);
            float ss = wave_sum(o[0] * o[0] + o[1] * o[1]); const float rs = rsqrtf(ss * (1.0f / 128.0f) + EPS);
            *(unsigned*)(yrow + 1024 + c0) = cvt_pk_bf16(o[0] * rs * hnw[lane * 2] * siluf_(bf2f(gwv & 0xffffu)), o[1] * rs * hnw[lane * 2 + 1] * siluf_(bf2f(gwv >> 16))); }
#pragma unroll
        for (int hh = 0; hh < 4; ++hh) { const int c0 = hh * 256 + lane * 4; const f32x4 o = *(const f32x4*)(orow + 2048 + c0); const u32x2 gwv = *(const u32x2*)(prow + PC_GG + c0);
            float ss = wave_sum((o[0] * o[0] + o[1] * o[1]) + (o[2] * o[2] + o[3] * o[3])); const float rs = rsqrtf(ss * (1.0f / 256.0f) + EPS);
            u32x2 w; w.x = cvt_pk_bf16(o[0] * rs * gnw[lane * 4] * siluf_(bf2f(gwv.x & 0xffffu)), o[1] * rs * gnw[lane * 4 + 1] * siluf_(bf2f(gwv.x >> 16)));
            w.y = cvt_pk_bf16(o[2] * rs * gnw[lane * 4 + 2] * siluf_(bf2f(gwv.y & 0xffffu)), o[3] * rs * gnw[lane * 4 + 3] * siluf_(bf2f(gwv.y >> 16)));
            *(u32x2*)(yrow + 2048 + c0) = w; }
    }
}

__device__ __forceinline__ void phase_final(const Args& a) {
    int tid = threadIdx.x; asm volatile("" : "+v"(tid));
    const int lane = tid & 63, wave = __builtin_amdgcn_readfirstlane(tid >> 6), gw = blockIdx.x * 8 + wave, NGW = gridDim.x * 8;
    const float* X = (const float*)(a.ws + WS_X); const float* ssq = (const float*)(a.ws + WS_CTL + CTL_SSQ) + (size_t)(3 * DEPTH) * MP; const float* fw = a.in[I_FINN];
    for (int r = gw; r < NTOK; r += NGW) {
        const float rs = rsqrtf(ssq[r] * (1.0f / DM) + EPS);
        float* o = r < NPROMPT ? a.out + O_YP + (size_t)r * DM : a.out + O_YS + (size_t)(r - NPROMPT) * DM;
#pragma unroll
        for (int j = 0; j < 8; ++j) { const f32x4 v = *(const f32x4*)(X + (size_t)r * DM + 4 * lane + 256 * j), w = *(const f32x4*)(fw + 4 * lane + 256 * j);
            *(f32x4*)(o + 4 * lane + 256 * j) = v * rs * w; }
    }
}

__global__ void __launch_bounds__(512, 2) fwd(Args args) {
    extern __shared__ __attribute__((aligned(16))) unsigned char lds_raw[];
    LAS unsigned char* lds = (LAS unsigned char*)lds_raw;
    volatile LAS unsigned* MISC = (volatile LAS unsigned*)(lds + MISC_OFF);
    const int G = gridDim.x;
    unsigned char* ws = args.ws;
    unsigned* ctl = (unsigned*)(ws + WS_CTL);
    for (int u = threadIdx.x; u < (LDS_BYTES - 131072) / 4; u += 512) ((LAS unsigned*)(lds + 131072))[u] = 0u;
    __syncthreads();
    XcdBarrier bar; bar.bar = ctl + CW_BAR; bar.x = 0; bar.st = nullptr;
    const int lo = args.ph_lo, hi = args.ph_hi;
    const bool multi = (hi - lo) > 1;
    if (multi) bar = xcd_barrier_post(ctl + CW_BAR, MISC + 8);
#define IN(k) (lo <= (k) && (k) < hi)
#define SEAM(k) do { if (IN(k) && IN((k) + 1)) xcd_barrier(bar); } while (0)
    float* ssq = (float*)(ws + WS_CTL + CTL_SSQ);
    float* X = (float*)(ws + WS_X); bf16_t* XB = (bf16_t*)(ws + WS_XB); bf16_t* ACT = (bf16_t*)(ws + WS_ACT); bf16_t* PROJ = (bf16_t*)(ws + WS_PROJ);
    bf16_t* Y = (bf16_t*)(ws + WS_Y); float* PART = (float*)(ws + WS_PART); bf16_t* MRG = (bf16_t*)(ws + WS_MRG);
    int ph = 0;
    if (PHON(0) && IN(ph)) { for (int rep = 0; rep < NREP(0); ++rep) phase_prologue(args, lds); } SEAM(ph); ++ph;
    for (int it = 0; it < 3 * DEPTH; ++it) {
        const int l = it / 3, kind = it - 3 * l;
        unsigned char* wl = ws + WS_W + (size_t)l * WL_STRIDE;
        if (kind != 1) {
            const int si = 3 * l + (kind == 0 ? 0 : 2);
            if (PHON(1) && IN(ph)) { pg8::Gemm g{XB, (const bf16_t*)(wl + (kind == 0 ? WL_GU1 : WL_GU2)), DM, DM, DM}; pg8::Order<1> S; S.init(MP / 256, 2 * DFF / 256, G, (int)blockIdx.x);
                pg8::EpiSwiGLU E{ACT, ssq + (size_t)si * MP}; pg8::gemm_phase(lds, g, S, E); } SEAM(ph); ++ph;
            if (PHON(2) && IN(ph)) { pg8::Gemm g{ACT, (const bf16_t*)(wl + (kind == 0 ? WL_D1 : WL_D2)), DFF, DFF, DFF}; pg8::Order<1> S; S.init(MP / 256, DM / 256, G, (int)blockIdx.x);
                pg8::EpiResid E{X, XB, ssq + (size_t)(si + 1) * MP, 0.5f}; pg8::gemm_phase(lds, g, S, E); } SEAM(ph); ++ph;
        } else {
            if (PHON(3) && IN(ph)) { pg8::Gemm g{XB, (const bf16_t*)(wl + WL_IN), DM, DM, DM}; pg8::Order<1> S; S.init(MP / 256, INP / 256, G, (int)blockIdx.x);
                pg8::EpiProj E{PROJ, ssq + (size_t)(3 * l + 1) * MP}; pg8::gemm_phase(lds, g, S, E); } SEAM(ph); ++ph;
            if (PHON(4) && IN(ph)) { for (int rep = 0; rep < NREP(4); ++rep) phase_prep(args, l, lds); } SEAM(ph); ++ph;
            if (PHON(5) && IN(ph)) { for (int rep = 0; rep < NREP(5); ++rep) phase_scan(args, l, lds); } SEAM(ph); ++ph;
            if (PHON(6) && IN(ph)) { for (int rep = 0; rep < NREP(6); ++rep) phase_post(args, l); } SEAM(ph); ++ph;
            if (PHON(7) && IN(ph)) { pg8::Gemm g{Y, (const bf16_t*)(wl + WL_BR), 3072, 3072, 1024}; pg8::Order<3> S; S.init(MP / 256, DM / 256, G, (int)blockIdx.x);
                pg8::EpiBranch E{PROJ, PART, MRG}; pg8::gemm_phase(lds, g, S, E); } SEAM(ph); ++ph;
            if (PHON(8) && IN(ph)) { pg8::Gemm g{MRG, (const bf16_t*)(wl + WL_OUT), DM, DM, DM}; pg8::Order<1> S; S.init(MP / 256, DM / 256, G, (int)blockIdx.x);
                pg8::EpiResid E{X, XB, ssq + (size_t)(3 * l + 2) * MP, 1.0f}; pg8::gemm_phase(lds, g, S, E); } SEAM(ph); ++ph;
        }
    }
    if (PHON(9) && IN(ph)) { phase_final(args); } ++ph;
#undef IN
#undef SEAM
}
constexpr int N_PHASES = 1 + DEPTH * 10 + 1;

extern "C" void kernel_launch(void* const* d_in, const int* in_sizes, int n_in, void* d_out, int out_size, void* d_ws, size_t ws_size, hipStream_t stream) {
    static int grid = 0;
    if (grid == 0) {
        if (n_in != 30 || (size_t)out_size != O_END || ws_size < WS_END) { fprintf(stderr, "kernel_launch: unexpected problem: n_in %d out %d ws %zu (need %zu)\n", n_in, out_size, ws_size, (size_t)WS_END); grid = -1; return; }
        int dev = 0, cus = 0, per_cu = 0;
        if (hipGetDevice(&dev) != hipSuccess || hipDeviceGetAttribute(&cus, hipDeviceAttributeMultiprocessorCount, dev) != hipSuccess) { grid = -1; return; }
        if (hipFuncSetAttribute((const void*)fwd, hipFuncAttributeMaxDynamicSharedMemorySize, LDS_BYTES) != hipSuccess) { fprintf(stderr, "kernel_launch: hipFuncSetAttribute failed\n"); grid = -1; return; }
        if (hipOccupancyMaxActiveBlocksPerMultiprocessor(&per_cu, (const void*)fwd, 512, LDS_BYTES) != hipSuccess || per_cu < 1) fprintf(stderr, "kernel_launch: occupancy query reports %d\n", per_cu);
        (void)hipGetLastError();
        grid = cus;
    }
    if (grid < 0) return;
    (void)hipMemsetAsync((char*)d_ws + WS_CTL, 0, CTL_ZERO_BYTES, stream);
    Args a{};
    for (int i = 0; i < 30; ++i) a.in[i] = (const float*)d_in[i];
    a.out = (float*)d_out; a.ws = (unsigned char*)d_ws;
#if MK_PER_PHASE
    for (int p = 0; p < N_PHASES; ++p) { a.ph_lo = p; a.ph_hi = p + 1; hipLaunchKernelGGL(fwd, dim3(grid), dim3(512), LDS_BYTES, stream, a); }
#else
    a.ph_lo = 0; a.ph_hi = N_PHASES; hipLaunchKernelGGL(fwd, dim3(grid), dim3(512), LDS_BYTES, stream, a);
#endif
}
```

```cpp
#include <hip/hip_runtime.h>
#include <cstdio>
#include <cstdint>

#ifndef PHMASK
#define PHMASK 0xFFFF
#endif
#define PHON(k) ((PHMASK >> (k)) & 1)
#ifndef REP_SITE
#define REP_SITE -1
#endif
#ifndef REP_SKIP_EPI
#define REP_SKIP_EPI 0
#endif
#ifndef REP_MASK
#define REP_MASK 0
#endif
#define NREP(k) (((REP_SITE == (k)) || ((REP_MASK >> (k)) & 1)) ? 2 : 1)
#ifndef MK_PER_PHASE
#define MK_PER_PHASE 0
#endif

#define LAS __attribute__((address_space(3)))
#define GAS __attribute__((address_space(1)))
typedef unsigned short bf16_t;
typedef short bf16x8 __attribute__((ext_vector_type(8)));
typedef float f32x4 __attribute__((ext_vector_type(4)));
typedef float f32x2 __attribute__((ext_vector_type(2)));
typedef unsigned u32x4 __attribute__((ext_vector_type(4)));
typedef unsigned u32x2 __attribute__((ext_vector_type(2)));

constexpr int DM = 2048, DFF = 5632, SEQ = 2048, NB = 4, NPROMPT = NB * SEQ, NSAMP = 128, NTOK = NPROMPT + NSAMP, MP = 8448  , DEPTH = 2;
constexpr int INC = 15904, INP = 16128;
constexpr float EPS = 1e-6f;
constexpr int PC_Z = 0, PC_XBC = 1024, PC_HQ = 2560, PC_HF = 3584, PC_HI = 4608, PC_HG = 5632, PC_GQ = 6656, PC_GK = 7168, PC_GV = 7680, PC_GG = 8704, PC_GATE = 9728, PC_DT = 15872, PC_GA = 15888;
constexpr size_t O_YP = 0, O_YS = 16777216, O_CP = 17039360, O_SP = 17076224, O_HP = 18124800, O_GP = 19173376, O_CS = 20221952, O_SS = 21401600, O_HS = 54956032, O_GS = 88510464, O_END = 122064896;

constexpr size_t MiB = 1u << 20;
constexpr size_t WS_CTL = 0, CTL_ZERO_BYTES = 1 * MiB;
constexpr size_t WS_LB = 1 * MiB, WS_DT = 2 * MiB, WS_LGA = 3 * MiB, WS_XC = 20 * MiB, WS_X = 45 * MiB, WS_XB = 111 * MiB, WS_ACT = 144 * MiB, WS_PROJ = 235 * MiB,
                 WS_O = 495 * MiB, WS_Y = 594 * MiB, WS_PART = 644 * MiB, WS_MRG = 710 * MiB, WS_W = 743 * MiB;
constexpr size_t WL_GU1 = 0, WL_D1 = 44 * MiB, WL_IN = 66 * MiB, WL_BR = 129 * MiB, WL_OUT = 141 * MiB, WL_GU2 = 149 * MiB, WL_D2 = 193 * MiB, WL_STRIDE = 215 * MiB;
constexpr size_t WS_SLAB = WS_W + 2 * WL_STRIDE;
constexpr size_t WS_END = WS_SLAB + 33 * MiB;
constexpr int CW_TK = 16384;
constexpr int CW_BAR = 4096;
constexpr size_t CTL_SSQ = 512 * 1024;
constexpr int LDS_BYTES = 147456;
constexpr int MISC_OFF = 131072 + 320;

__device__ __forceinline__ float bf2f(unsigned b) { return __uint_as_float(b << 16); }
__device__ __forceinline__ unsigned f2bf(float f) { unsigned u = __float_as_uint(f); return (u + 0x7fffu + ((u >> 16) & 1u)) >> 16; }

__device__ __forceinline__ unsigned cvt_pk_bf16(float lo, float hi) { typedef __bf16 bf2_ __attribute__((ext_vector_type(2))); f32x2 v = {lo, hi}; bf2_ r = __builtin_convertvector(v, bf2_); return __builtin_bit_cast(unsigned, r); }
__device__ __forceinline__ float fast_rcp(float x) { return __builtin_amdgcn_rcpf(x); }
__device__ __forceinline__ float sigmoidf_(float x) { return fast_rcp(1.0f + __expf(-x)); }
__device__ __forceinline__ float siluf_(float x) { return x * sigmoidf_(x); }
__device__ __forceinline__ float softplusf_(float x) { return x > 20.f ? x : log1pf(__expf(x)); }
__device__ __forceinline__ float wave_sum(float v) {
#pragma unroll
    for (int o = 1; o < 64; o <<= 1) v += __shfl_xor(v, o);
    return v;
}
#define LDS_WAIT() asm volatile("s_waitcnt lgkmcnt(0)" ::: "memory")
#define VM_WAIT() asm volatile("s_waitcnt vmcnt(0)" ::: "memory")

#define XB_TMO      128
#define XB_XCNT(j)  (256  + 64 * (j))
#define XB_XSUB(j)  (1280 + 64 * (j))
#define XB_XGEN(j)  (2304 + 64 * (j))
#define XB_TOP      3328
#define XB_TOPGEN   3392
#define XCD_BAR_WORDS 3456
#define XB_SPIN_CAP (1u << 18)
__device__ __forceinline__ unsigned xb_ld(unsigned* p)              { return __hip_atomic_load(p, __ATOMIC_RELAXED, __HIP_MEMORY_SCOPE_AGENT); }
__device__ __forceinline__ unsigned xb_add(unsigned* p, unsigned v) { return __hip_atomic_fetch_add(p, v, __ATOMIC_RELAXED, __HIP_MEMORY_SCOPE_AGENT); }
__device__ __forceinline__ unsigned xb_xcc_id() { return (unsigned)__builtin_amdgcn_s_getreg((3 << 11) | 20) & 0xFu; }
#define XB_SPIN(cond, bar) do { unsigned _sp = 0; while (cond) { __builtin_amdgcn_s_sleep(1); \
    if ((++_sp & 255u) == 0u) { if (xb_ld(&(bar)[XB_TMO])) break; if (_sp > XB_SPIN_CAP) { atomicAdd(&(bar)[XB_TMO], 1u); break; } } } } while (0)
struct XcdBarrier { unsigned* bar; unsigned x; volatile LAS unsigned* st; };
__device__ __forceinline__ XcdBarrier xcd_barrier_post(unsigned* bar, volatile LAS unsigned* st) {
    XcdBarrier b; b.bar = bar; b.x = xb_xcc_id(); b.st = st;
    if (threadIdx.x == 0) (void)xb_add(&bar[XB_XCNT(b.x)], 1u);
    return b;
}
__device__ __forceinline__ void xcd_barrier_complete(unsigned* bar, unsigned x, unsigned& nloc, unsigned& nx) {
    const unsigned G = gridDim.x * gridDim.y * gridDim.z;
    unsigned sum, cnt, mine, sp = 0u;
    for (;;) {
        sum = 0u; cnt = 0u; mine = 0u;
#pragma unroll
        for (unsigned j = 0; j < 16; ++j) { const unsigned c = xb_ld(&bar[XB_XCNT(j)]); sum += c; cnt += (c > 0u) ? 1u : 0u; mine = (j == x) ? c : mine; }
        if (sum == G) break;
        __builtin_amdgcn_s_sleep(1);
        if ((++sp & 255u) == 0u) { if (xb_ld(&bar[XB_TMO])) break; if (sp > XB_SPIN_CAP) { atomicAdd(&bar[XB_TMO], 1u); break; } }
    }
    nloc = mine > 0u ? mine : 1u; nx = cnt > 0u ? cnt : 1u;
}
__device__ __forceinline__ void xcd_barrier(const XcdBarrier& b) {
    asm volatile("s_waitcnt vmcnt(0)" ::: "memory");
    __syncthreads();
    if (threadIdx.x == 0) {
        unsigned* bar = b.bar;
        __builtin_amdgcn_s_waitcnt(0);
        unsigned nloc = b.st[0], nx = b.st[1];
        if (nloc == 0u) { xcd_barrier_complete(bar, b.x, nloc, nx); b.st[0] = nloc; b.st[1] = nx; }
        const unsigned old = xb_add(&bar[XB_XSUB(b.x)], 1u);
        const unsigned gen = old / nloc;
        if (old + 1u == (gen + 1u) * nloc) {
            __builtin_amdgcn_fence(__ATOMIC_RELEASE, "agent");
            asm volatile("s_waitcnt vmcnt(0)" ::: "memory");
            const unsigned og = xb_add(&bar[XB_TOP], 1u);
            const unsigned tg = og / nx;
            if (og + 1u == (tg + 1u) * nx) xb_add(&bar[XB_TOPGEN], 1u);
            else XB_SPIN(xb_ld(&bar[XB_TOPGEN]) == tg, bar);
            __builtin_amdgcn_fence(__ATOMIC_ACQUIRE, "agent");
            xb_add(&bar[XB_XGEN(b.x)], 1u);
            asm volatile("s_waitcnt vmcnt(0)" ::: "memory");
        } else {
            XB_SPIN(xb_ld(&bar[XB_XGEN(b.x)]) == gen, bar);
            __builtin_amdgcn_fence(__ATOMIC_ACQUIRE, "agent");
            asm volatile("s_waitcnt vmcnt(0)" ::: "memory");
        }
    }
    __syncthreads();
}

namespace pg8 {
constexpr int BM = 256, BK = 64, HALF = 128, HTB = HALF * BK * 2, STAGE_BYTES = 8 * HTB, NXCD = 8, WGM = 8;
__host__ __device__ __forceinline__ int lds_byte(int r, int c) { const int st = (r >> 4) * 2 + (c >> 5), rr = r & 15, cc = c & 31, ob = rr * 64 + cc * 2; return st * 1024 + (ob ^ (((ob >> 9) & 1) << 5)); }
__host__ __device__ __forceinline__ void stage_rc(int b, int& R, int& C) { const int st = b / 1024, sb = b % 1024, swz = sb ^ (((sb >> 9) & 1) << 5); R = (st >> 1) * 16 + swz / 64; C = (st & 1) * 32 + (swz % 64) / 2; }
__host__ __device__ __forceinline__ int perm32(int rho) { const int n = rho >> 4, i = rho & 15; return 8 * (i >> 2) + 4 * n + (i & 3); }

struct Unit { int pm, pn, kb, sp; };
struct Gemm { const bf16_t* A; const bf16_t* Bt; int lda, ldb, K; float* slab; unsigned* tk; };

template <int NK> struct Order {
    int nN, nwg, G, c, K, ns, npt, p0, NP;
    __device__ __forceinline__ void init(int nN_, int K_, int ns_, int G_, int c_) { nN = nN_; nwg = 32 * nN; G = G_; c = c_; K = K_; ns = ns_; npt = __builtin_amdgcn_readfirstlane(c < nwg ? (nwg - c + G - 1) / G : 0); NP = nN * NK * ns; p0 = __builtin_amdgcn_readfirstlane(((c - nwg % G) % G + G) % G); }
    __device__ __forceinline__ int nt(const Unit& u) const { return u.pm == 32 ? K / BK / ns : K / BK; }
    __device__ __forceinline__ int koff(const Unit& u) const { return u.kb * K + (u.pm == 32 ? u.sp * (K / ns) : 0); }
    __device__ __forceinline__ bool piece(const Unit& u) const { return u.pm == 32 && ns * NK > 1; }
    __device__ __forceinline__ int nsl() const { return ns * NK; }
    __device__ __forceinline__ int slab(const Unit& u) const { return (u.pn * NK + u.kb) * ns + u.sp; }
    __device__ __forceinline__ bool next(int i, Unit& u) const {
        const bool prompt = i < npt * NK;
        const int it = i / NK, kbP = i - it * NK;
        int wgid = it * G + c; { const int q = nwg / NXCD, r = nwg % NXCD, xcd = wgid % NXCD, off = wgid / NXCD; wgid = (xcd < r ? xcd * (q + 1) : r * (q + 1) + (xcd - r) * q) + off; }
        const int nig = WGM * nN, gid = wgid / nig, fm = gid * WGM, gsz = (32 - fm) < WGM ? (32 - fm) : WGM;
        const int pmP = fm + ((wgid % nig) % gsz), pnP = (wgid % nig) / gsz;
        const int j = i - npt * NK, q = p0 + j * G, t = q / ns, spS = q - t * ns, pnS = t / NK, kbS = t - pnS * NK;
        u.pm = __builtin_amdgcn_readfirstlane(prompt ? pmP : 32); u.pn = __builtin_amdgcn_readfirstlane(prompt ? pnP : pnS);
        u.kb = __builtin_amdgcn_readfirstlane(prompt ? kbP : kbS); u.sp = __builtin_amdgcn_readfirstlane(prompt ? 0 : spS);
        return prompt || q < NP;
    }
};


struct EpiSwiGLU {
    static constexpr bool PERM = true;
    __device__ __forceinline__ void piece_pre(f32x4 (&)[2][2][4][2], const Unit&, int, int, int, int) const {}
    bf16_t* O; const float* ssq;
    __device__ __forceinline__ void operator()(const f32x4 (&acc)[2][2][4][2], const Unit& u, int wr, int wc, int fr, int fq, bool pc) const {
        const int row0 = u.pm * BM + wr * 64 + fr, col0 = u.pn * HALF + wc * 32 + 8 * fq;
#pragma unroll
        for (int ai = 0; ai < 2; ++ai)
#pragma unroll
            for (int m = 0; m < 4; ++m) {
                const int row = row0 + ai * HALF + m * 16;
                const float rs = rsqrtf(ssq[row] * (1.0f / DM) + EPS);
                float h[8];
#pragma unroll
                for (int n = 0; n < 2; ++n)
#pragma unroll
                    for (int j = 0; j < 4; ++j) { const float g = acc[ai][0][m][n][j] * rs, up = acc[ai][1][m][n][j] * rs; h[n * 4 + j] = siluf_(g) * up; }
                u32x4 w; w.x = cvt_pk_bf16(h[0], h[1]); w.y = cvt_pk_bf16(h[2], h[3]); w.z = cvt_pk_bf16(h[4], h[5]); w.w = cvt_pk_bf16(h[6], h[7]);
                *(u32x4*)(O + (size_t)row * DFF + col0) = w;
            }
    }
};
struct EpiResid {
    static constexpr bool PERM = false;
    __device__ __forceinline__ void piece_pre(f32x4 (&)[2][2][4][2], const Unit&, int, int, int, int) const {}
    float* X; bf16_t* XB; float* ssq_out; float scale;
    __device__ __forceinline__ void operator()(const f32x4 (&acc)[2][2][4][2], const Unit& u, int wr, int wc, int fr, int fq, bool pc) const {
        const int row0 = u.pm * BM + wr * 64 + fr, col0 = u.pn * BM + wc * 32 + 4 * fq;
#pragma unroll
        for (int ai = 0; ai < 2; ++ai)
#pragma unroll
            for (int m = 0; m < 4; ++m) {
                const int row = row0 + ai * HALF + m * 16; float ss = 0.f;
                float* xp = X + (size_t)row * DM + col0; bf16_t* bp = XB + (size_t)row * DM + col0;
#pragma unroll
                for (int bj = 0; bj < 2; ++bj)
#pragma unroll
                    for (int n = 0; n < 2; ++n) {
                        const f32x4 b = *(const f32x4*)(xp + bj * HALF + n * 16);
                        const f32x4 o = b + acc[ai][bj][m][n] * scale;
                        *(f32x4*)(xp + bj * HALF + n * 16) = o;
                        ss += (o[0] * o[0] + o[1] * o[1]) + (o[2] * o[2] + o[3] * o[3]);
                        u32x2 w; w.x = cvt_pk_bf16(o[0], o[1]); w.y = cvt_pk_bf16(o[2], o[3]);
                        *(u32x2*)(bp + bj * HALF + n * 16) = w;
                    }
                ss += __shfl_xor(ss, 16); ss += __shfl_xor(ss, 32);
                if (fq == 0) atomicAdd(ssq_out + row, ss);
            }
    }
};
struct EpiProj {
    static constexpr bool PERM = true;
    __device__ __forceinline__ void piece_pre(f32x4 (&)[2][2][4][2], const Unit&, int, int, int, int) const {}
    bf16_t* O; const float* ssq;
    __device__ __forceinline__ void operator()(const f32x4 (&acc)[2][2][4][2], const Unit& u, int wr, int wc, int fr, int fq, bool pc) const {
        const int row0 = u.pm * BM + wr * 64 + fr, col0 = u.pn * BM + wc * 32 + 8 * fq;
#pragma unroll
        for (int ai = 0; ai < 2; ++ai)
#pragma unroll
            for (int m = 0; m < 4; ++m) {
                const int row = row0 + ai * HALF + m * 16;
                const float rs = rsqrtf(ssq[row] * (1.0f / DM) + EPS);
#pragma unroll
                for (int bj = 0; bj < 2; ++bj) { const f32x4 v0 = acc[ai][bj][m][0] * rs, v1 = acc[ai][bj][m][1] * rs;
                    u32x4 w; w.x = cvt_pk_bf16(v0[0], v0[1]); w.y = cvt_pk_bf16(v0[2], v0[3]); w.z = cvt_pk_bf16(v1[0], v1[1]); w.w = cvt_pk_bf16(v1[2], v1[3]);
                    *(u32x4*)(O + (size_t)row * INP + col0 + bj * HALF) = w; }
            }
    }
};
struct EpiBranch {
    static constexpr bool PERM = true;
    const bf16_t* PROJ; float* PART; bf16_t* MRG;
    __device__ __forceinline__ void piece_pre(f32x4 (&acc)[2][2][4][2], const Unit& u, int wr, int wc, int fr, int fq) const {
        const int row0 = u.pm * BM + wr * 64 + fr, col0 = u.pn * BM + wc * 32 + 8 * fq;
#pragma unroll
        for (int m = 0; m < 4; ++m)
#pragma unroll
            for (int bj = 0; bj < 2; ++bj) { const u32x4 gw = *(const u32x4*)(PROJ + (size_t)(row0 + m * 16) * INP + PC_GATE + u.kb * DM + col0 + bj * HALF);
#pragma unroll
                for (int j = 0; j < 4; ++j) { const unsigned w = gw[j]; const int e = 2 * j; acc[0][bj][m][e >> 2][e & 3] *= sigmoidf_(bf2f(w & 0xffffu)); acc[0][bj][m][(e + 1) >> 2][(e + 1) & 3] *= sigmoidf_(bf2f(w >> 16)); } }
    }
    __device__ __forceinline__ void operator()(const f32x4 (&acc)[2][2][4][2], const Unit& u, int wr, int wc, int fr, int fq, bool pc) const {
        const int row0 = u.pm * BM + wr * 64 + fr, col0 = u.pn * BM + wc * 32 + 8 * fq;
#pragma unroll
        for (int ai = 0; ai < 2; ++ai)
#pragma unroll
            for (int m = 0; m < 4; ++m) {
                const int row = row0 + ai * HALF + m * 16;
#pragma unroll
                for (int bj = 0; bj < 2; ++bj) {
                    const int col = col0 + bj * HALF;
                    const u32x4 gw = *(const u32x4*)(PROJ + (size_t)row * INP + PC_GATE + u.kb * DM + col);
                    float v[8];
#pragma unroll
                    for (int j = 0; j < 4; ++j) { const unsigned w = gw[j]; const float g0 = sigmoidf_(bf2f(w & 0xffffu)), g1 = sigmoidf_(bf2f(w >> 16));
                        const int e = 2 * j; v[e] = g0 * acc[ai][bj][m][e >> 2][e & 3]; v[e + 1] = g1 * acc[ai][bj][m][(e + 1) >> 2][(e + 1) & 3]; }
                    if (pc) {
#pragma unroll
                        for (int j = 0; j < 8; ++j) v[j] = acc[ai][bj][m][j >> 2][j & 3]; }
                    float* pp = PART + (size_t)row * DM + col;
                    if (!pc && u.kb != 0) { const f32x4 p0 = *(const f32x4*)pp, p1 = *(const f32x4*)(pp + 4);
#pragma unroll
                        for (int j = 0; j < 4; ++j) { v[j] += p0[j]; v[4 + j] += p1[j]; } }
                    if (!pc && u.kb != 2) { *(f32x4*)pp = (f32x4){v[0], v[1], v[2], v[3]}; *(f32x4*)(pp + 4) = (f32x4){v[4], v[5], v[6], v[7]}; }
                    else { u32x4 w; w.x = cvt_pk_bf16(v[0], v[1]); w.y = cvt_pk_bf16(v[2], v[3]); w.z = cvt_pk_bf16(v[4], v[5]); w.w = cvt_pk_bf16(v[6], v[7]);
                        *(u32x4*)(MRG + (size_t)row * DM + col) = w; }
                }
            }
    }
};

template <class Epi, class Sched>
__device__ __forceinline__ void gemm_phase(LAS unsigned char* lds, const Gemm g, const Sched& S, const Epi& E) {
    int tid = threadIdx.x; asm volatile("" : "+v"(tid));
    const int wid = __builtin_amdgcn_readfirstlane(tid >> 6), lane = tid & 63, wr = wid >> 2, wc = wid & 3, fr = lane & 15, fq = lane >> 4;
    unsigned voffA[2], voffB[2];
#pragma unroll
    for (int i = 0; i < 2; ++i) { int R, C; stage_rc(tid * 16 + i * 8192, R, C); const int Rb = Epi::PERM ? ((R & ~31) + perm32(R & 31)) : R;
        voffA[i] = (unsigned)(R * g.lda + C) * 2u; voffB[i] = (unsigned)(Rb * g.ldb + C) * 2u; }
    const size_t kstep = (size_t)(BK * 2);
    const size_t hstepA = (size_t)HALF * g.lda * 2, hstepB = (size_t)HALF * g.ldb * 2;
    const size_t tstepA = 2 * hstepA, tstepB = 2 * hstepB;
    const unsigned ldsw = (unsigned)wid * 1024u;
    const int aoff = lds_byte(wr * 64 + fr, fq * 8), boff = lds_byte(wc * 32 + fr, fq * 8);
#define PG8_SA(b, h) (((b) * 2 + (h)) * HTB)
#define PG8_SB(b, h) ((4 + (b) * 2 + (h)) * HTB)
#define PG8_STAGE(bufoff, gbase, voff) do { _Pragma("unroll") for (int _i = 0; _i < 2; ++_i) \
        __builtin_amdgcn_global_load_lds((const unsigned*)((const char*)(gbase) + (voff)[_i]), (LAS unsigned*)(lds + (bufoff) + ldsw + _i * 8192), 16, 0, 0); } while (0)
#define PG8_LDA(dst, b, h) do { _Pragma("unroll") for (int m = 0; m < 4; ++m) _Pragma("unroll") for (int k = 0; k < 2; ++k) dst[m][k] = *(const LAS bf16x8*)(lds + PG8_SA(b, h) + aoff + m * 2048 + k * 1024); } while (0)
#define PG8_LDB(dst, b, h) do { _Pragma("unroll") for (int n = 0; n < 2; ++n) _Pragma("unroll") for (int k = 0; k < 2; ++k) dst[n][k] = *(const LAS bf16x8*)(lds + PG8_SB(b, h) + boff + n * 2048 + k * 1024); } while (0)
#define PG8_MMA(ai, bj, At, Bt) do { __builtin_amdgcn_s_setprio(1); _Pragma("unroll") for (int m = 0; m < 4; ++m) _Pragma("unroll") for (int n = 0; n < 2; ++n) _Pragma("unroll") for (int k = 0; k < 2; ++k) \
        acc[ai][bj][m][n] = __builtin_amdgcn_mfma_f32_16x16x32_bf16(Bt[n][k], At[m][k], acc[ai][bj][m][n], 0, 0, 0); __builtin_amdgcn_s_setprio(0); } while (0)
#define PG8_WAIT_V(n) asm volatile("s_waitcnt vmcnt(" #n ")" ::: "memory")
#define PG8_WAIT_L(n) asm volatile("s_waitcnt lgkmcnt(" #n ")" ::: "memory")
#define PG8_BAR __builtin_amdgcn_s_barrier()
#define PG8_SCHED __builtin_amdgcn_sched_barrier(0)
    Unit cur, nxt; int ui = 0;
    if (!S.next(0, cur)) return;
    f32x4 acc[2][2][4][2];
#pragma unroll
    for (int a = 0; a < 2; ++a)
#pragma unroll
        for (int b = 0; b < 2; ++b)
#pragma unroll
            for (int m = 0; m < 4; ++m)
#pragma unroll
                for (int n = 0; n < 2; ++n) acc[a][b][m][n] = (f32x4){0.f, 0.f, 0.f, 0.f};
    bf16x8 At[4][2], B0[2][2], B1[2][2];
    const char* cA = (const char*)g.A + (size_t)cur.pm * tstepA + (size_t)S.koff(cur) * 2; const char* cB = (const char*)g.Bt + (size_t)cur.pn * tstepB + (size_t)S.koff(cur) * 2;
    PG8_STAGE(PG8_SB(0, 0), cB, voffB); PG8_STAGE(PG8_SB(0, 1), cB + hstepB, voffB); PG8_STAGE(PG8_SA(0, 0), cA, voffA); PG8_STAGE(PG8_SA(0, 1), cA + hstepA, voffA);
    if (wr == 1) PG8_BAR;
    PG8_WAIT_V(2); PG8_BAR;
    PG8_STAGE(PG8_SB(1, 0), cB + kstep, voffB); PG8_STAGE(PG8_SA(1, 0), cA + kstep, voffA); PG8_STAGE(PG8_SB(1, 1), cB + hstepB + kstep, voffB);
    PG8_WAIT_V(6); PG8_BAR;
    for (;;) {
        const bool has_next = S.next(ui + 1, nxt);
        const char* nA = has_next ? (const char*)g.A + (size_t)nxt.pm * tstepA + (size_t)S.koff(nxt) * 2 : cA;
        const char* nB = has_next ? (const char*)g.Bt + (size_t)nxt.pn * tstepB + (size_t)S.koff(nxt) * 2 : cB;
        const int nt = S.nt(cur);
        for (int t = 0; t < nt; t += 2) {
            const bool last = (t == nt - 2);
            const char* a1 = cA + (size_t)(t + 1) * kstep;
            const char* a2 = last ? nA : cA + (size_t)(t + 2) * kstep; const char* b2 = last ? nB : cB + (size_t)(t + 2) * kstep;
            const char* a3 = a2 + kstep; const char* b3 = b2 + kstep;
            PG8_LDB(B0, 0, 0); PG8_LDB(B1, 0, 1); PG8_SCHED; PG8_LDA(At, 0, 0); PG8_STAGE(PG8_SA(1, 1), a1 + hstepA, voffA);
            PG8_WAIT_V(8); PG8_WAIT_L(0); PG8_BAR; PG8_MMA(0, 0, At, B0); PG8_MMA(0, 1, At, B1); PG8_BAR; PG8_SCHED;
            PG8_LDA(At, 0, 1); PG8_STAGE(PG8_SB(0, 0), b2, voffB); PG8_STAGE(PG8_SB(0, 1), b2 + hstepB, voffB); PG8_STAGE(PG8_SA(0, 0), a2, voffA);
            PG8_WAIT_V(8); PG8_WAIT_L(0); PG8_BAR; PG8_MMA(1, 0, At, B0); PG8_MMA(1, 1, At, B1); PG8_BAR; PG8_SCHED;
            PG8_LDB(B0, 1, 0); PG8_LDB(B1, 1, 1); PG8_SCHED; PG8_LDA(At, 1, 0); PG8_STAGE(PG8_SA(0, 1), a2 + hstepA, voffA);
            PG8_WAIT_V(8); PG8_WAIT_L(0); PG8_BAR; PG8_MMA(0, 0, At, B0); PG8_MMA(0, 1, At, B1); PG8_BAR; PG8_SCHED;
            PG8_LDA(At, 1, 1); PG8_STAGE(PG8_SB(1, 0), b3, voffB); PG8_STAGE(PG8_SB(1, 1), b3 + hstepB, voffB); PG8_STAGE(PG8_SA(1, 0), a3, voffA);
            PG8_WAIT_V(8); PG8_WAIT_L(0); PG8_BAR; PG8_MMA(1, 0, At, B0); PG8_MMA(1, 1, At, B1); PG8_BAR; PG8_SCHED;
        }
        if (wr == 0) PG8_BAR;
        bool run_epi = true;
        if (S.piece(cur)) {
            E.piece_pre(acc, cur, wr, wc, fr, fq);
            { unsigned long long* sl = (unsigned long long*)(g.slab + (size_t)S.slab(cur) * 32768) + (size_t)tid * 2;
#pragma unroll
              for (int bj = 0; bj < 2; ++bj)
#pragma unroll
                  for (int m = 0; m < 4; ++m)
#pragma unroll
                      for (int n = 0; n < 2; ++n) { const int idx = (bj * 4 + m) * 2 + n; const f32x4 v = acc[0][bj][m][n];
                          __hip_atomic_store(sl + idx * 1024, ((unsigned long long)__float_as_uint(v[1]) << 32) | __float_as_uint(v[0]), __ATOMIC_RELAXED, __HIP_MEMORY_SCOPE_AGENT);
                          __hip_atomic_store(sl + idx * 1024 + 1, ((unsigned long long)__float_as_uint(v[3]) << 32) | __float_as_uint(v[2]), __ATOMIC_RELAXED, __HIP_MEMORY_SCOPE_AGENT); } }
            PG8_WAIT_V(0); PG8_BAR;
            volatile LAS unsigned* flagw = (volatile LAS unsigned*)(lds + MISC_OFF + 64);
            if (tid == 0) { const unsigned tkt = __hip_atomic_fetch_add(g.tk + 64 * cur.pn, 1u, __ATOMIC_RELAXED, __HIP_MEMORY_SCOPE_AGENT); flagw[0] = tkt; }
            PG8_WAIT_L(0); PG8_BAR;
            run_epi = (flagw[0] == (unsigned)(S.nsl() - 1));
            if (run_epi) {
                __builtin_amdgcn_fence(__ATOMIC_ACQUIRE, "agent"); PG8_WAIT_V(0);
#pragma unroll
                for (int bj = 0; bj < 2; ++bj)
#pragma unroll
                    for (int m = 0; m < 4; ++m)
#pragma unroll
                        for (int n = 0; n < 2; ++n) { acc[0][bj][m][n] = (f32x4){0.f, 0.f, 0.f, 0.f}; acc[1][bj][m][n] = (f32x4){0.f, 0.f, 0.f, 0.f}; }
                const float* sb = g.slab + (size_t)cur.pn * S.nsl() * 32768 + (size_t)tid * 4;
#pragma unroll 1
                for (int sp = 0; sp < S.nsl(); ++sp) {
                    f32x4 tv[16];
#pragma unroll
                    for (int q = 0; q < 16; ++q) tv[q] = *(const f32x4*)(sb + (size_t)sp * 32768 + q * 2048);
#pragma unroll
                    for (int bj = 0; bj < 2; ++bj)
#pragma unroll
                        for (int m = 0; m < 4; ++m)
#pragma unroll
                            for (int n = 0; n < 2; ++n) acc[0][bj][m][n] += tv[(bj * 4 + m) * 2 + n]; }
            }
        }
        if (run_epi) E(acc, cur, wr, wc, fr, fq, S.piece(cur));
        if (!has_next) break;
#pragma unroll
        for (int a = 0; a < 2; ++a)
#pragma unroll
            for (int b = 0; b < 2; ++b)
#pragma unroll
                for (int m = 0; m < 4; ++m)
#pragma unroll
                    for (int n = 0; n < 2; ++n) acc[a][b][m][n] = (f32x4){0.f, 0.f, 0.f, 0.f};
        cur = nxt; cA = nA; cB = nB; ++ui;
        if (wr == 1) PG8_BAR;
    }
    PG8_WAIT_V(0);
    PG8_BAR;
#undef PG8_SA
#undef PG8_SB
#undef PG8_STAGE
#undef PG8_LDA
#undef PG8_LDB
#undef PG8_MMA
#undef PG8_WAIT_V
#undef PG8_WAIT_L
#undef PG8_BAR
#undef PG8_SCHED
}
}

struct Args { const float* in[30]; float* out; unsigned char* ws; int ph_lo, ph_hi; };
enum { I_XP = 0, I_XS, I_SCONV, I_SSSM, I_SHGRN, I_SGLA, I_F1N, I_F1GU, I_F1D, I_MIXN, I_WIN, I_CONVW, I_CONVB, I_DTB, I_ALOG, I_DSKIP, I_MNORM, I_LBL, I_HNORM, I_GWD, I_GBD, I_GNORM,
       I_WBM, I_WBH, I_WBG, I_WOUT, I_F2N, I_F2GU, I_F2D, I_FINN };

__device__ __forceinline__ int map_col(int map, int np) {
    if (map == 0) return np;
    if (map == 1) { const int pn = np >> 8, w = np & 255; return w < 128 ? 128 * pn + w : DFF + 128 * pn + (w - 128); }
    if (np < 2560) return np;
    if (np < PC_GATE) return np + 16;
    if (np < PC_DT) return np + 32;
    if (np < PC_GA) return 2560 + (np - PC_DT);
    if (np < INC) return 9744 + (np - PC_GA);
    return -1;
}
struct TrItem { const float* W; const float* kscale; bf16_t* WT; int N, ldk, koff, map, k0, n0; };
__device__ __forceinline__ void tr_load(const TrItem& T, int tid, f32x4 (&v)[8]) {
    const int c4 = (tid & 31) * 4, src = map_col(T.map, T.n0 + c4);
#pragma unroll
    for (int i = 0; i < 8; ++i) { const int r = (tid >> 5) + 16 * i; v[i] = (f32x4){0.f, 0.f, 0.f, 0.f};
        if (src >= 0) { v[i] = *(const f32x4*)(T.W + (size_t)(T.k0 + r) * T.N + src); if (T.kscale) v[i] = v[i] * T.kscale[T.k0 + r]; } }
}
__device__ __forceinline__ void tr_store(const TrItem& T, int tid, const f32x4 (&v)[8], LAS float* tile) {
    const int c4 = (tid & 31) * 4;
#pragma unroll
    for (int i = 0; i < 8; ++i) { const int r = (tid >> 5) + 16 * i; LAS float* p = tile + r * 129 + c4; p[0] = v[i][0]; p[1] = v[i][1]; p[2] = v[i][2]; p[3] = v[i][3]; }
    LDS_WAIT(); __syncthreads();
    const int kg = tid & 15;
#pragma unroll
    for (int j = 0; j < 4; ++j) { const int n = (tid >> 4) + 32 * j; const LAS float* sp = tile + (8 * kg) * 129 + n;
        u32x4 o; o.x = cvt_pk_bf16(sp[0], sp[129]); o.y = cvt_pk_bf16(sp[2 * 129], sp[3 * 129]); o.z = cvt_pk_bf16(sp[4 * 129], sp[5 * 129]); o.w = cvt_pk_bf16(sp[6 * 129], sp[7 * 129]);
        *(u32x4*)(T.WT + (size_t)(T.n0 + n) * T.ldk + T.koff + T.k0 + 8 * kg) = o; }
    LDS_WAIT(); __syncthreads();
}
__device__ __forceinline__ TrItem tr_item(const Args& a, int it) {
    constexpr int IT_GU = 16 * 88, IT_D = 44 * 16, IT_IN = 16 * 126, IT_B = 8 * 16, IT_O = 16 * 16;
    constexpr int IT_LAYER = 2 * IT_GU + 2 * IT_D + IT_IN + 3 * IT_B + IT_O;
    const int l = it / IT_LAYER; int r = it - l * IT_LAYER;
    unsigned char* wl = a.ws + WS_W + (size_t)l * WL_STRIDE;
    TrItem T; int nblk;
    if (r < IT_GU) { T = TrItem{a.in[I_F1GU] + (size_t)l * DM * 2 * DFF, a.in[I_F1N] + l * DM, (bf16_t*)(wl + WL_GU1), 2 * DFF, DM, 0, 1, 0, 0}; nblk = 88; }
    else if ((r -= IT_GU) < IT_D) { T = TrItem{a.in[I_F1D] + (size_t)l * DFF * DM, nullptr, (bf16_t*)(wl + WL_D1), DM, DFF, 0, 0, 0, 0}; nblk = 16; }
    else if ((r -= IT_D) < IT_IN) { T = TrItem{a.in[I_WIN] + (size_t)l * DM * INC, a.in[I_MIXN] + l * DM, (bf16_t*)(wl + WL_IN), INC, DM, 0, 2, 0, 0}; nblk = 126; }
    else if ((r -= IT_IN) < IT_B) { T = TrItem{a.in[I_WBM] + (size_t)l * 1024 * DM, nullptr, (bf16_t*)(wl + WL_BR), DM, 3072, 0, 0, 0, 0}; nblk = 16; }
    else if ((r -= IT_B) < IT_B) { T = TrItem{a.in[I_WBH] + (size_t)l * 1024 * DM, nullptr, (bf16_t*)(wl + WL_BR), DM, 3072, 1024, 0, 0, 0}; nblk = 16; }
    else if ((r -= IT_B) < IT_B) { T = TrItem{a.in[I_WBG] + (size_t)l * 1024 * DM, nullptr, (bf16_t*)(wl + WL_BR), DM, 3072, 2048, 0, 0, 0}; nblk = 16; }
    else if ((r -= IT_B) < IT_O) { T = TrItem{a.in[I_WOUT] + (size_t)l * DM * DM, nullptr, (bf16_t*)(wl + WL_OUT), DM, DM, 0, 0, 0, 0}; nblk = 16; }
    else if ((r -= IT_O) < IT_GU) { T = TrItem{a.in[I_F2GU] + (size_t)l * DM * 2 * DFF, a.in[I_F2N] + l * DM, (bf16_t*)(wl + WL_GU2), 2 * DFF, DM, 0, 1, 0, 0}; nblk = 88; }
    else { r -= IT_GU; T = TrItem{a.in[I_F2D] + (size_t)l * DFF * DM, nullptr, (bf16_t*)(wl + WL_D2), DM, DFF, 0, 0, 0, 0}; nblk = 16; }
    T.k0 = 128 * (r / nblk); T.n0 = 128 * (r % nblk);
    return T;
}
constexpr int TR_ITEMS = DEPTH * (2 * 16 * 88 + 2 * 44 * 16 + 16 * 126 + 3 * 8 * 16 + 16 * 16);

struct Ctx {
    LAS unsigned char* lds; const Args* a; unsigned char* ws; int tid, lane, wave, G, gw, NGW;
};

__device__ __forceinline__ void phase_prologue(const Args& a, LAS unsigned char* lds) {
    int tid = threadIdx.x; asm volatile("" : "+v"(tid));
    const int lane = tid & 63, wave = __builtin_amdgcn_readfirstlane(tid >> 6), gw = blockIdx.x * 8 + wave, NGW = gridDim.x * 8;
    unsigned char* ws = a.ws;
    { LAS float* tile = (LAS float*)lds; const int G = gridDim.x;
      int it = blockIdx.x; f32x4 v[8];
      if (it < TR_ITEMS) { const TrItem T = tr_item(a, it); tr_load(T, tid, v); }
      while (it < TR_ITEMS) {
          const TrItem T = tr_item(a, it); f32x4 cur[8];
#pragma unroll
          for (int i = 0; i < 8; ++i) cur[i] = v[i];
          const int nx = it + G;
          if (nx < TR_ITEMS) { const TrItem Tn = tr_item(a, nx); tr_load(Tn, tid, v); }
          tr_store(T, tid, cur, tile);
          it = nx;
      } }
    float* X = (float*)(ws + WS_X); bf16_t* XB = (bf16_t*)(ws + WS_XB); float* ssq0 = (float*)(ws + WS_CTL + CTL_SSQ);
    for (int r = gw; r < MP; r += NGW) {
        const float* src = r < NPROMPT ? a.in[I_XP] + (size_t)r * DM : (r < NTOK ? a.in[I_XS] + (size_t)(r - NPROMPT) * DM : nullptr);
        float ss = 0.f;
#pragma unroll
        for (int j = 0; j < 8; ++j) { f32x4 v = (f32x4){0.f, 0.f, 0.f, 0.f}; if (src) v = *(const f32x4*)(src + 4 * lane + 256 * j);
            *(f32x4*)(X + (size_t)r * DM + 4 * lane + 256 * j) = v; ss += (v[0] * v[0] + v[1] * v[1]) + (v[2] * v[2] + v[3] * v[3]);
            u32x2 w; w.x = cvt_pk_bf16(v[0], v[1]); w.y = cvt_pk_bf16(v[2], v[3]); *(u32x2*)(XB + (size_t)r * DM + 4 * lane + 256 * j) = w; }
        ss = wave_sum(ss); if (lane == 0) ssq0[r] = ss;
        if (r >= NTOK) { bf16_t* y = (bf16_t*)(ws + WS_Y) + (size_t)r * 3072;
#pragma unroll
            for (int j = 0; j < 6; ++j) *(u32x4*)(y + 8 * lane + 512 * j) = (u32x4){0u, 0u, 0u, 0u}; }
    }
    float* LB = (float*)(ws + WS_LB);
    for (int c = gw * 64 + lane; c < 1024; c += NGW * 64) {
        float mx = -1e30f; for (int l = 0; l < DEPTH; ++l) mx = fmaxf(mx, a.in[I_LBL][l * 1024 + c]);
        float den = 0.f; for (int l = 0; l < DEPTH; ++l) den += expf(a.in[I_LBL][l * 1024 + c] - mx);
        float cum = 0.f; const float sm0 = expf(a.in[I_LBL][c] - mx) / den;
        for (int l = 0; l < DEPTH; ++l) { cum += expf(a.in[I_LBL][l * 1024 + c] - mx) / den; LB[l * 1024 + c] = cum - sm0; }
    }
}

__device__ __forceinline__ void unpack8(const u32x4 w, float (&x)[8]) {
#pragma unroll
    for (int j = 0; j < 4; ++j) { x[2 * j] = bf2f(w[j] & 0xffffu); x[2 * j + 1] = bf2f(w[j] >> 16); }
}
__device__ __forceinline__ void phase_prep(const Args& a, int l, LAS unsigned char* lds) {
    int tid = threadIdx.x; asm volatile("" : "+v"(tid));
    const int lane = tid & 63, wave = __builtin_amdgcn_readfirstlane(tid >> 6), gw = blockIdx.x * 8 + wave, NGW = gridDim.x * 8;
    unsigned char* ws = a.ws;
    const bf16_t* PROJ = (const bf16_t*)(ws + WS_PROJ); bf16_t* XC = (bf16_t*)(ws + WS_XC); float* DT = (float*)(ws + WS_DT); float* LGA = (float*)(ws + WS_LGA);
    LAS float* swd = (LAS float*)lds;
    for (int i = tid; i < 16 * 512; i += 512) swd[i] = a.in[I_GWD][(size_t)l * 16 * 512 + i];
    for (int i = tid; i < 512; i += 512) swd[8192 + i] = a.in[I_GBD][l * 512 + i];
    __syncthreads();
    const float* cw = a.in[I_CONVW] + (size_t)l * 4 * 1536; const float* cb = a.in[I_CONVB] + l * 1536;
    for (int r = gw; r < NTOK; r += NGW) {
        const bool samp = r >= NPROMPT; const int t = samp ? 0 : (r & (SEQ - 1)), s = r - NPROMPT, b = r >> 11;
        const bf16_t* prow = PROJ + (size_t)r * INP;
#pragma unroll 1
        for (int i = 0; i < 3; ++i) {
            const int ch = lane * 8 + 512 * i;
            float c[8], x[8];
            { const f32x4 b0 = *(const f32x4*)(cb + ch), b1 = *(const f32x4*)(cb + ch + 4);
#pragma unroll
              for (int j = 0; j < 4; ++j) { c[j] = b0[j]; c[4 + j] = b1[j]; } }
            unpack8(*(const u32x4*)(prow + PC_XBC + ch), x);
            { const f32x4 w0 = *(const f32x4*)(cw + 3 * 1536 + ch), w1 = *(const f32x4*)(cw + 3 * 1536 + ch + 4);
#pragma unroll
              for (int j = 0; j < 4; ++j) { c[j] += w0[j] * x[j]; c[4 + j] += w1[j] * x[4 + j]; } }
            if (samp) { float* op = a.out + O_CS + (((size_t)l * NSAMP + s) * 3 + 2) * 1536 + ch; *(f32x4*)op = (f32x4){x[0], x[1], x[2], x[3]}; *(f32x4*)(op + 4) = (f32x4){x[4], x[5], x[6], x[7]}; }
            else if (t >= SEQ - 3) { float* op = a.out + O_CP + (((size_t)l * NB + b) * 3 + (t - (SEQ - 3))) * 1536 + ch; *(f32x4*)op = (f32x4){x[0], x[1], x[2], x[3]}; *(f32x4*)(op + 4) = (f32x4){x[4], x[5], x[6], x[7]}; }
#pragma unroll
            for (int k = 1; k <= 3; ++k) {
                if (samp) { const float* sp = a.in[I_SCONV] + (((size_t)l * NSAMP + s) * 3 + (3 - k)) * 1536 + ch; const f32x4 p0 = *(const f32x4*)sp, p1 = *(const f32x4*)(sp + 4);
#pragma unroll
                    for (int j = 0; j < 4; ++j) { x[j] = p0[j]; x[4 + j] = p1[j]; }
                    if (k <= 2) { float* op = a.out + O_CS + (((size_t)l * NSAMP + s) * 3 + (2 - k)) * 1536 + ch; *(f32x4*)op = p0; *(f32x4*)(op + 4) = p1; } }
                else if (t - k >= 0) unpack8(*(const u32x4*)(prow - (size_t)k * INP + PC_XBC + ch), x);
                else {
#pragma unroll
                    for (int j = 0; j < 8; ++j) x[j] = 0.f; }
                const f32x4 w0 = *(const f32x4*)(cw + (3 - k) * 1536 + ch), w1 = *(const f32x4*)(cw + (3 - k) * 1536 + ch + 4);
#pragma unroll
                for (int j = 0; j < 4; ++j) { c[j] += w0[j] * x[j]; c[4 + j] += w1[j] * x[4 + j]; }
            }
            u32x4 w; w.x = cvt_pk_bf16(siluf_(c[0]), siluf_(c[1])); w.y = cvt_pk_bf16(siluf_(c[2]), siluf_(c[3])); w.z = cvt_pk_bf16(siluf_(c[4]), siluf_(c[5])); w.w = cvt_pk_bf16(siluf_(c[6]), siluf_(c[7]));
            *(u32x4*)(XC + (size_t)r * 1536 + ch) = w;
        }
        if (lane < 16) DT[(size_t)r * 16 + lane] = softplusf_(bf2f(prow[PC_DT + lane]) + a.in[I_DTB][l * 16 + lane]);
        { float ga[16];
          unpack8(*(const u32x4*)(prow + PC_GA), *(float(*)[8])&ga[0]); unpack8(*(const u32x4*)(prow + PC_GA + 8), *(float(*)[8])&ga[8]);
          float pre[8];
#pragma unroll
          for (int e = 0; e < 8; ++e) pre[e] = swd[8192 + lane * 8 + e];
#pragma unroll
          for (int i = 0; i < 16; ++i)
#pragma unroll
              for (int e = 0; e < 8; ++e) pre[e] += ga[i] * swd[i * 512 + lane * 8 + e];
          float lo[8];
#pragma unroll
          for (int e = 0; e < 8; ++e) lo[e] = -(fmaxf(-pre[e], 0.f) + log1pf(__expf(-fabsf(pre[e])))) * (1.0f / 16.0f);
          float* op = LGA + (size_t)r * 512 + lane * 8;
          *(f32x4*)op = (f32x4){lo[0], lo[1], lo[2], lo[3]}; *(f32x4*)(op + 4) = (f32x4){lo[4], lo[5], lo[6], lo[7]}; }
    }
}

constexpr int CS_QD = 0, CS_KD = 17408, CS_QE = 34816, CS_KET = 52224, CS_VT = 70656, CS_ST = 79872, CS_P = 97280, CS_TOT = 106496, CS_EGL = 108544, CS_GS = 109056, CS_END = 109312;
constexpr int SMP_LDS = 114688;
#define CFRAG(base, RS, rowblk, ks) (*(const LAS bf16x8*)(lds + (base) + ((rowblk) * 16 + fr) * (RS) + ((ks) * 32 + fq * 8) * 2))
template <int MIX>
__device__ __forceinline__ void chunk_unit(const Args& a, int l, int b, int h, int j0, LAS unsigned char* lds, const int tid) {
    unsigned char* ws = a.ws;
    const int lane = tid & 63, wave = __builtin_amdgcn_readfirstlane(tid >> 6), d = tid & 127, tq = tid >> 7, fr = lane & 15, fq = lane >> 4;
    const bf16_t* src = (MIX == 0) ? (const bf16_t*)(ws + WS_XC) : (const bf16_t*)(ws + WS_PROJ);
    constexpr int SS = (MIX == 0) ? 1536 : INP;
    const int qcol = (MIX == 0) ? 1280 + (h >> 3) * 128 : (MIX == 1 ? PC_HQ + h * 128 : PC_GQ + h * 128);
    const int kcol = (MIX == 0) ? 1024 + (h >> 3) * 128 : (MIX == 1 ? PC_HF + h * 128 : PC_GK + h * 128);
    const int vcol = (MIX == 0) ? h * 64 : (MIX == 1 ? PC_HI + h * 128 + j0 : PC_GV + h * 256 + j0);
    const int ocol = (MIX == 0) ? h * 64 : (MIX == 1 ? 1024 + h * 128 + j0 : 2048 + h * 256 + j0);
    const float* DT = (const float*)(ws + WS_DT); const float* LGA = (const float*)(ws + WS_LGA); float* O = (float*)(ws + WS_O);
    const float aH = (MIX == 0) ? -__expf(a.in[I_ALOG][l * 16 + h]) : 0.f;
    const float lb = (MIX == 1) ? ((const float*)(ws + WS_LB))[l * 1024 + h * 128 + d] : 0.f;
    const float dskip = (MIX == 0) ? a.in[I_DSKIP][l * 16 + h] : 0.f;
    constexpr float QS = 0.08838834764831845f;
    LAS float* tot = (LAS float*)(lds + CS_TOT); LAS float* eGl = (LAS float*)(lds + CS_EGL); LAS float* Gs = (LAS float*)(lds + CS_GS);
    f32x4 S[4];
#pragma unroll
    for (int i = 0; i < 4; ++i) S[i] = (f32x4){0.f, 0.f, 0.f, 0.f};
    __syncthreads();
    for (int i = tid; i < 17408 / 4; i += 512) ((LAS unsigned*)(lds + CS_ST))[i] = 0u;
    unsigned rq[16], rk[16]; float rg[16]; u32x4 rv; float rdt = 0.f;
    const int vs = tid >> 3, v8 = (tid & 7) * 8;
#define CLOAD(c) do { const size_t rb_ = (size_t)b * SEQ + (size_t)(c) * 64; \
    _Pragma("unroll") for (int i = 0; i < 16; ++i) { const size_t r = rb_ + 16 * tq + i; rq[i] = src[r * SS + qcol + d]; rk[i] = src[r * SS + kcol + d]; \
        rg[i] = (MIX == 0) ? DT[r * 16 + h] : ((MIX == 2) ? LGA[r * 512 + h * 128 + d] : 0.f); } \
    rv = *(const u32x4*)(src + (rb_ + vs) * SS + vcol + v8); if (MIX == 0) rdt = DT[(rb_ + vs) * 16 + h]; } while (0)
    CLOAD(0);
    for (int c = 0; c < SEQ / 64; ++c) {
        const size_t rb = (size_t)b * SEQ + (size_t)c * 64;
        float g[16], kv[16], qv[16];
#pragma unroll
        for (int i = 0; i < 16; ++i) { const float q0 = bf2f(rq[i]), k0 = bf2f(rk[i]);
            if (MIX == 0) { qv[i] = q0; kv[i] = k0; g[i] = rg[i] * aH; }
            else if (MIX == 1) { qv[i] = siluf_(q0) * QS; const float sg = sigmoidf_(k0); const float f = lb + (1.f - lb) * sg; g[i] = __logf(fmaxf(f, 1.17549435e-38f)); kv[i] = (1.f - lb) * fast_rcp(1.f + __expf(k0)); }
            else { qv[i] = q0 * QS; kv[i] = k0; g[i] = rg[i]; } }
#pragma unroll
        for (int i = 1; i < 16; ++i) g[i] += g[i - 1];
        tot[tq * 128 + d] = g[15];
        float xv[8];
#pragma unroll
        for (int j = 0; j < 4; ++j) { xv[2 * j] = bf2f(rv[j] & 0xffffu); xv[2 * j + 1] = bf2f(rv[j] >> 16); }
        if (MIX == 0) {
#pragma unroll
            for (int j = 0; j < 8; ++j) xv[j] *= rdt; }
#pragma unroll
        for (int e = 0; e < 8; ++e) *(LAS unsigned short*)(lds + CS_VT + (v8 + e) * 144 + vs * 2) = (unsigned short)f2bf(xv[e]);
        LDS_WAIT(); __syncthreads();
        const float t0 = tot[d], t1 = tot[128 + d], t2 = tot[256 + d], t3 = tot[384 + d];
        const float prefix = tq == 0 ? 0.f : (tq == 1 ? t0 : (tq == 2 ? t0 + t1 : t0 + t1 + t2)), Gref = t0 + t1, Glast = (t0 + t1) + (t2 + t3);
        unsigned kep[8];
#pragma unroll
        for (int i = 0; i < 16; ++i) { const float G = prefix + g[i]; const int t = 16 * tq + i;
            float qd, kd;
            if (MIX == 0) { qd = qv[i]; kd = kv[i]; } else { qd = qv[i] * __expf(fminf(G - Gref, 80.f)); kd = kv[i] * __expf(fminf(Gref - G, 80.f)); }
            const float qe = qv[i] * __expf(G), ke = kv[i] * __expf(Glast - G);
            *(LAS unsigned short*)(lds + CS_QD + t * 272 + d * 2) = (unsigned short)f2bf(qd);
            *(LAS unsigned short*)(lds + CS_KD + t * 272 + d * 2) = (unsigned short)f2bf(kd);
            *(LAS unsigned short*)(lds + CS_QE + t * 272 + d * 2) = (unsigned short)f2bf(qe);
            if (i & 1) kep[i >> 1] |= f2bf(ke) << 16; else kep[i >> 1] = f2bf(ke);
            if (MIX == 0 && d == 0) Gs[t] = G; }
        *(LAS u32x4*)(lds + CS_KET + d * 144 + tq * 32) = (u32x4){kep[0], kep[1], kep[2], kep[3]};
        *(LAS u32x4*)(lds + CS_KET + d * 144 + tq * 32 + 16) = (u32x4){kep[4], kep[5], kep[6], kep[7]};
        if (tq == 0) eGl[d] = __expf(Glast);
        if (c + 1 < SEQ / 64) CLOAD(c + 1);
        LDS_WAIT(); __syncthreads();
        const int tb = wave >> 1, half = wave & 1;
        f32x4 ao[2];
        { bf16x8 qe[4];
#pragma unroll
          for (int ks = 0; ks < 4; ++ks) qe[ks] = CFRAG(CS_QE, 272, tb, ks);
#pragma unroll
          for (int vv = 0; vv < 2; ++vv) { ao[vv] = (f32x4){0.f, 0.f, 0.f, 0.f};
#pragma unroll
              for (int ks = 0; ks < 4; ++ks) ao[vv] = __builtin_amdgcn_mfma_f32_16x16x32_bf16(CFRAG(CS_ST, 272, 2 * half + vv, ks), qe[ks], ao[vv], 0, 0, 0); } }
        { bf16x8 qd[4];
#pragma unroll
          for (int ks = 0; ks < 4; ++ks) qd[ks] = CFRAG(CS_QD, 272, tb, ks);
          const int t = 16 * tb + fr;
#pragma unroll
          for (int ss = 0; ss < 2; ++ss) { const int sb = 2 * half + ss; f32x4 aa = (f32x4){0.f, 0.f, 0.f, 0.f};
              if (sb <= tb) {
#pragma unroll
                  for (int ks = 0; ks < 4; ++ks) aa = __builtin_amdgcn_mfma_f32_16x16x32_bf16(CFRAG(CS_KD, 272, sb, ks), qd[ks], aa, 0, 0, 0);
#pragma unroll
                  for (int rg_ = 0; rg_ < 4; ++rg_) { const int sidx = 16 * sb + 4 * fq + rg_; const bool keep = sidx <= t;
                      float vA = aa[rg_]; if (MIX == 0) vA *= __expf(keep ? Gs[t] - Gs[sidx] : 0.f); aa[rg_] = keep ? vA : 0.f; } }
              u32x2 pw; pw.x = cvt_pk_bf16(aa[0], aa[1]); pw.y = cvt_pk_bf16(aa[2], aa[3]);
              *(LAS u32x2*)(lds + CS_P + t * 144 + (16 * sb + 4 * fq) * 2) = pw; } }
        LDS_WAIT(); __syncthreads();
        { bf16x8 p[2];
#pragma unroll
          for (int ks = 0; ks < 2; ++ks) p[ks] = CFRAG(CS_P, 144, tb, ks);
#pragma unroll
          for (int vv = 0; vv < 2; ++vv)
#pragma unroll
              for (int ks = 0; ks < 2; ++ks) ao[vv] = __builtin_amdgcn_mfma_f32_16x16x32_bf16(CFRAG(CS_VT, 144, 2 * half + vv, ks), p[ks], ao[vv], 0, 0, 0); }
        { const size_t r = rb + 16 * tb + fr;
#pragma unroll
          for (int vv = 0; vv < 2; ++vv) { const int v0 = 16 * (2 * half + vv) + 4 * fq; f32x4 o = ao[vv];
              if (MIX == 0) { const u32x2 xw = *(const u32x2*)(src + r * SS + vcol + v0); o[0] += dskip * bf2f(xw.x & 0xffffu); o[1] += dskip * bf2f(xw.x >> 16); o[2] += dskip * bf2f(xw.y & 0xffffu); o[3] += dskip * bf2f(xw.y >> 16); }
              *(f32x4*)(O + r * 3072 + ocol + v0) = o; } }
        { bf16x8 ke[2];
#pragma unroll
          for (int ks = 0; ks < 2; ++ks) ke[ks] = CFRAG(CS_KET, 144, wave, ks);
          const f32x4 ev = *(const LAS f32x4*)(eGl + 16 * wave + 4 * fq);
#pragma unroll
          for (int vb = 0; vb < 4; ++vb) { S[vb] = S[vb] * ev;
#pragma unroll
              for (int ks = 0; ks < 2; ++ks) S[vb] = __builtin_amdgcn_mfma_f32_16x16x32_bf16(ke[ks], CFRAG(CS_VT, 144, vb, ks), S[vb], 0, 0, 0);
              u32x2 sw; sw.x = cvt_pk_bf16(S[vb][0], S[vb][1]); sw.y = cvt_pk_bf16(S[vb][2], S[vb][3]);
              *(LAS u32x2*)(lds + CS_ST + (16 * vb + fr) * 272 + (16 * wave + 4 * fq) * 2) = sw; } }
        LDS_WAIT(); __syncthreads();
    }
#undef CLOAD
#pragma unroll
    for (int vb = 0; vb < 4; ++vb) { const int v = 16 * vb + fr, d0 = 16 * wave + 4 * fq;
        if (MIX == 0) { float* sp = a.out + O_SP + ((((size_t)l * NB + b) * 16 + h) * 64 + v) * 128 + d0; *(f32x4*)sp = S[vb]; }
        else if (MIX == 1) { float* sp = a.out + O_HP + (((size_t)l * NB + b) * 8 + h) * 16384 + (size_t)d0 * 128 + j0 + v;
#pragma unroll
            for (int rg_ = 0; rg_ < 4; ++rg_) sp[rg_ * 128] = S[vb][rg_]; }
        else { float* sp = a.out + O_GP + (((size_t)l * NB + b) * 4 + h) * 32768 + (size_t)d0 * 256 + j0 + v;
#pragma unroll
            for (int rg_ = 0; rg_ < 4; ++rg_) sp[rg_ * 256] = S[vb][rg_]; } }
}
#undef CFRAG

__device__ __forceinline__ void sample_unit_wave(const Args& a, int l, int su, LAS float* wl, const int lane) {
    unsigned char* ws = a.ws;
    const int mix = su >> 11, rem = su & 2047, s = rem >> 4, hs = rem & 15;
    const size_t r = (size_t)NPROMPT + s;
    const bf16_t* PROJ = (const bf16_t*)(ws + WS_PROJ) + r * INP; const bf16_t* XC = (const bf16_t*)(ws + WS_XC) + r * 1536; const float* DT = (const float*)(ws + WS_DT) + r * 16; const float* LGA = (const float*)(ws + WS_LGA) + r * 512;
    float* O = (float*)(ws + WS_O) + r * 3072;
    LAS float* wq = wl; LAS float* wk = wl + 128; LAS float* wd = wl + 256;
    constexpr float QS = 0.08838834764831845f;
    float v, xs = 0.f, dskip = 0.f; int ocol;
    if (mix == 0) { const int h = hs; const float dt = DT[h], dec = __expf(dt * -__expf(a.in[I_ALOG][l * 16 + h])); dskip = a.in[I_DSKIP][l * 16 + h];
#pragma unroll
        for (int e = 0; e < 2; ++e) { const int d = lane + 64 * e; wq[d] = bf2f(XC[1280 + (h >> 3) * 128 + d]); wk[d] = bf2f(XC[1024 + (h >> 3) * 128 + d]); wd[d] = dec; }
        xs = bf2f(XC[h * 64 + lane]); v = dt * xs; ocol = h * 64; }
    else if (mix == 1) { const int h = hs >> 1, j0 = 64 * (hs & 1); const float* LB = (const float*)(ws + WS_LB) + l * 1024 + h * 128;
#pragma unroll
        for (int e = 0; e < 2; ++e) { const int d = lane + 64 * e; const float zf = bf2f(PROJ[PC_HF + h * 128 + d]), lbv = LB[d];
            wq[d] = siluf_(bf2f(PROJ[PC_HQ + h * 128 + d])) * QS; wd[d] = lbv + (1.f - lbv) * sigmoidf_(zf); wk[d] = (1.f - lbv) * fast_rcp(1.f + __expf(zf)); }
        v = bf2f(PROJ[PC_HI + h * 128 + j0 + lane]); ocol = 1024 + h * 128 + j0; }
    else { const int h = hs >> 2, j0 = 64 * (hs & 3);
#pragma unroll
        for (int e = 0; e < 2; ++e) { const int d = lane + 64 * e; wq[d] = bf2f(PROJ[PC_GQ + h * 128 + d]) * QS; wk[d] = bf2f(PROJ[PC_GK + h * 128 + d]); wd[d] = __expf(LGA[h * 128 + d]); }
        v = bf2f(PROJ[PC_GV + h * 256 + j0 + lane]); ocol = 2048 + h * 256 + j0; }
    LDS_WAIT(); asm volatile("" ::: "memory");
    float acc = 0.f;
    if (mix == 0) { const size_t sb = ((((size_t)l * NSAMP + s) * 16 + hs) * 64 + lane) * 128; const float* sin = a.in[I_SSSM] + sb; float* sout = a.out + O_SS + sb;
#pragma unroll 1
        for (int blk = 0; blk < 4; ++blk) { f32x4 st[8];
#pragma unroll
            for (int i = 0; i < 8; ++i) st[i] = *(const f32x4*)(sin + blk * 32 + 4 * i);
#pragma unroll
            for (int i = 0; i < 8; ++i) { const f32x4 qq = *(const LAS f32x4*)(wq + blk * 32 + 4 * i), kk = *(const LAS f32x4*)(wk + blk * 32 + 4 * i), dd = *(const LAS f32x4*)(wd + blk * 32 + 4 * i);
                f32x4 n = dd * st[i] + kk * v; acc += (qq[0] * n[0] + qq[1] * n[1]) + (qq[2] * n[2] + qq[3] * n[3]); *(f32x4*)(sout + blk * 32 + 4 * i) = n; } } }
    else { const int h = mix == 1 ? hs >> 1 : hs >> 2, j0 = mix == 1 ? 64 * (hs & 1) : 64 * (hs & 3), ld = mix == 1 ? 128 : 256;
        const size_t sb = (mix == 1 ? (((size_t)l * NSAMP + s) * 8 + h) * 16384 : (((size_t)l * NSAMP + s) * 4 + h) * 32768) + j0 + lane;
        const float* sin = (mix == 1 ? a.in[I_SHGRN] : a.in[I_SGLA]) + sb; float* sout = a.out + (mix == 1 ? O_HS : O_GS) + sb;
#pragma unroll 1
        for (int blk = 0; blk < 8; ++blk) { float st[16];
#pragma unroll
            for (int i = 0; i < 16; ++i) st[i] = sin[(size_t)(blk * 16 + i) * ld];
#pragma unroll
            for (int i4 = 0; i4 < 4; ++i4) { const f32x4 qq = *(const LAS f32x4*)(wq + blk * 16 + 4 * i4), kk = *(const LAS f32x4*)(wk + blk * 16 + 4 * i4), dd = *(const LAS f32x4*)(wd + blk * 16 + 4 * i4);
#pragma unroll
                for (int e = 0; e < 4; ++e) { const float n = dd[e] * st[4 * i4 + e] + kk[e] * v; acc += qq[e] * n; sout[(size_t)(blk * 16 + 4 * i4 + e) * ld] = n; } } } }
    O[ocol + lane] = acc + dskip * xs;
    LDS_WAIT(); asm volatile("" ::: "memory");
}
constexpr int CW_SQ = 2048;
__device__ __forceinline__ void phase_scan(const Args& a, int l, LAS unsigned char* lds) {
    int tid = threadIdx.x; asm volatile("" : "+v"(tid));
    const int lane = tid & 63, wave = __builtin_amdgcn_readfirstlane(tid >> 6);
    const int w = blockIdx.x;
    if (w < 192) { const int mix = w / 64, rem = w % 64, b = rem / 16, hs = rem % 16;
        if (mix == 0) chunk_unit<0>(a, l, b, hs, 0, lds, tid);
        else if (mix == 1) chunk_unit<1>(a, l, b, hs >> 1, 64 * (hs & 1), lds, tid);
        else chunk_unit<2>(a, l, b, hs >> 2, 64 * (hs & 3), lds, tid);
    }
    unsigned* head = (unsigned*)(a.ws + WS_CTL) + CW_SQ + 64 * l;
    LAS float* wl = (LAS float*)(lds + SMP_LDS + wave * 2048);
    for (;;) { unsigned su = 0; if (lane == 0) su = __hip_atomic_fetch_add(head, 1u, __ATOMIC_RELAXED, __HIP_MEMORY_SCOPE_AGENT);
        su = __builtin_amdgcn_readfirstlane(su); if (su >= 6144u) break;
        sample_unit_wave(a, l, (int)su, wl, lane); }
}

__device__ __forceinline__ void phase_post(const Args& a, int l) {
    int tid = threadIdx.x; asm volatile("" : "+v"(tid));
    const int lane = tid & 63, wave = __builtin_amdgcn_readfirstlane(tid >> 6), gw = blockIdx.x * 8 + wave, NGW = gridDim.x * 8;
    unsigned char* ws = a.ws;
    const bf16_t* PROJ = (const bf16_t*)(ws + WS_PROJ); const float* O = (const float*)(ws + WS_O); bf16_t* Y = (bf16_t*)(ws + WS_Y);
    const float* mnw = a.in[I_MNORM] + l * 1024; const float* hnw = a.in[I_HNORM] + l * 128; const float* gnw = a.in[I_GNORM] + l * 256;
    for (int r = gw; r < NTOK; r += NGW) {
        const float* orow = O + (size_t)r * 3072; const bf16_t* prow = PROJ + (size_t)r * INP; bf16_t* yrow = Y + (size_t)r * 3072;
#pragma unroll
        for (int g = 0; g < 2; ++g) { const int c0 = g * 512 + lane * 8; float y[8]; float ss = 0.f;
            const f32x4 o0 = *(const f32x4*)(orow + c0), o1 = *(const f32x4*)(orow + c0 + 4); const u32x4 zw = *(const u32x4*)(prow + PC_Z + c0);
#pragma unroll
            for (int j = 0; j < 4; ++j) { y[2 * j] = (j < 2 ? o0[2 * j] : o1[2 * j - 4]) * siluf_(bf2f(zw[j] & 0xffffu)); y[2 * j + 1] = (j < 2 ? o0[2 * j + 1] : o1[2 * j - 3]) * siluf_(bf2f(zw[j] >> 16)); }
#pragma unroll
            for (int j = 0; j < 8; ++j) ss += y[j] * y[j];
            ss = wave_sum(ss); const float rs = rsqrtf(ss * (1.0f / 512.0f) + EPS);
            u32x4 w; w.x = cvt_pk_bf16(y[0] * rs * mnw[c0], y[1] * rs * mnw[c0 + 1]); w.y = cvt_pk_bf16(y[2] * rs * mnw[c0 + 2], y[3] * rs * mnw[c0 + 3]); w.z = cvt_pk_bf16(y[4] * rs * mnw[c0 + 4], y[5] * rs * mnw[c0 + 5]); w.w = cvt_pk_bf16(y[6] * rs * mnw[c0 + 6], y[7] * rs * mnw[c0 + 7]);
            *(u32x4*)(yrow + c0) = w; }
#pragma unroll
        for (int hh = 0; hh < 8; ++hh) { const int c0 = hh * 128 + lane * 2; const f32x2 o = *(const f32x2*)(orow + 1024 + c0); const unsigned gwv = *(const unsigned*)(prow + PC_HG + c0);
            float ss = wave_sum(o[0] * o[0] + o[1] * o[1]); const float rs = rsqrtf(ss * (1.0f / 128.0f) + EPS);
            *(unsigned*)(yrow + 1024 + c0) = cvt_pk_bf16(o[0] * rs * hnw[lane * 2] * siluf_(bf2f(gwv & 0xffffu)), o[1] * rs * hnw[lane * 2 + 1] * siluf_(bf2f(gwv >> 16))); }
#pragma unroll
        for (int hh = 0; hh < 4; ++hh) { const int c0 = hh * 256 + lane * 4; const f32x4 o = *(const f32x4*)(orow + 2048 + c0); const u32x2 gwv = *(const u32x2*)(prow + PC_GG + c0);
            float ss = wave_sum((o[0] * o[0] + o[1] * o[1]) + (o[2] * o[2] + o[3] * o[3])); const float rs = rsqrtf(ss * (1.0f / 256.0f) + EPS);
            u32x2 w; w.x = cvt_pk_bf16(o[0] * rs * gnw[lane * 4] * siluf_(bf2f(gwv.x & 0xffffu)), o[1] * rs * gnw[lane * 4 + 1] * siluf_(bf2f(gwv.x >> 16)));
            w.y = cvt_pk_bf16(o[2] * rs * gnw[lane * 4 + 2] * siluf_(bf2f(gwv.y & 0xffffu)), o[3] * rs * gnw[lane * 4 + 3] * siluf_(bf2f(gwv.y >> 16)));
            *(u32x2*)(yrow + 2048 + c0) = w; }
    }
}

__device__ __forceinline__ void phase_final(const Args& a) {
    int tid = threadIdx.x; asm volatile("" : "+v"(tid));
    const int lane = tid & 63, wave = __builtin_amdgcn_readfirstlane(tid >> 6), gw = blockIdx.x * 8 + wave, NGW = gridDim.x * 8;
    const float* X = (const float*)(a.ws + WS_X); const float* ssq = (const float*)(a.ws + WS_CTL + CTL_SSQ) + (size_t)(3 * DEPTH) * MP; const float* fw = a.in[I_FINN];
    for (int r = gw; r < NTOK; r += NGW) {
        const float rs = rsqrtf(ssq[r] * (1.0f / DM) + EPS);
        float* o = r < NPROMPT ? a.out + O_YP + (size_t)r * DM : a.out + O_YS + (size_t)(r - NPROMPT) * DM;
#pragma unroll
        for (int j = 0; j < 8; ++j) { const f32x4 v = *(const f32x4*)(X + (size_t)r * DM + 4 * lane + 256 * j), w = *(const f32x4*)(fw + 4 * lane + 256 * j);
            *(f32x4*)(o + 4 * lane + 256 * j) = v * rs * w; }
    }
}

__global__ void __launch_bounds__(512, 2) fwd(Args args) {
    extern __shared__ __attribute__((aligned(16))) unsigned char lds_raw[];
    LAS unsigned char* lds = (LAS unsigned char*)lds_raw;
    volatile LAS unsigned* MISC = (volatile LAS unsigned*)(lds + MISC_OFF);
    const int G = gridDim.x;
    unsigned char* ws = args.ws;
    unsigned* ctl = (unsigned*)(ws + WS_CTL);
    for (int u = threadIdx.x; u < (LDS_BYTES - 131072) / 4; u += 512) ((LAS unsigned*)(lds + 131072))[u] = 0u;
    __syncthreads();
    XcdBarrier bar; bar.bar = ctl + CW_BAR; bar.x = 0; bar.st = nullptr;
    const int lo = args.ph_lo, hi = args.ph_hi;
    const bool multi = (hi - lo) > 1;
    if (multi) bar = xcd_barrier_post(ctl + CW_BAR, MISC + 8);
#define IN(k) (lo <= (k) && (k) < hi)
#define SEAM(k) do { if (IN(k) && IN((k) + 1)) xcd_barrier(bar); } while (0)
#define OPQ(w) unsigned char* w = args.ws; asm volatile("" : "+s"(w))
#define SSQ(w, i) ((float*)((w) + WS_CTL + CTL_SSQ) + (size_t)(i) * MP)
#define TKP(w) ((unsigned*)((w) + WS_CTL) + CW_TK + 4096 * ph)
    int ph = 0;
    if (PHON(0) && IN(ph)) { for (int rep = 0; rep < NREP(0); ++rep) phase_prologue(args, lds); } SEAM(ph); ++ph;
    for (int it = 0; it < 3 * DEPTH; ++it) {
        const int l = it / 3, kind = it - 3 * l;
        const size_t wlo = WS_W + (size_t)l * WL_STRIDE;
        if (kind != 1) {
            const int si = 3 * l + (kind == 0 ? 0 : 2);
            if (PHON(1) && IN(ph)) { OPQ(w); pg8::Gemm g{(bf16_t*)(w + WS_XB), (const bf16_t*)(w + wlo + (kind == 0 ? WL_GU1 : WL_GU2)), DM, DM, DM, (float*)(w + WS_SLAB), TKP(w)}; pg8::Order<1> S; S.init(2 * DFF / 256, DM, 1, G, (int)blockIdx.x);
                pg8::EpiSwiGLU E{(bf16_t*)(w + WS_ACT), SSQ(w, si)}; pg8::gemm_phase(lds, g, S, E); } SEAM(ph); ++ph;
            if (PHON(2) && IN(ph)) { OPQ(w); pg8::Gemm g{(bf16_t*)(w + WS_ACT), (const bf16_t*)(w + wlo + (kind == 0 ? WL_D1 : WL_D2)), DFF, DFF, DFF, (float*)(w + WS_SLAB), TKP(w)}; pg8::Order<1> S; S.init(DM / 256, DFF, 11, G, (int)blockIdx.x);
                pg8::EpiResid E{(float*)(w + WS_X), (bf16_t*)(w + WS_XB), SSQ(w, si + 1), 0.5f}; pg8::gemm_phase(lds, g, S, E); } SEAM(ph); ++ph;
        } else {
            if (PHON(3) && IN(ph)) { OPQ(w); pg8::Gemm g{(bf16_t*)(w + WS_XB), (const bf16_t*)(w + wlo + WL_IN), DM, DM, DM, (float*)(w + WS_SLAB), TKP(w)}; pg8::Order<1> S; S.init(INP / 256, DM, 4, G, (int)blockIdx.x);
                pg8::EpiProj E{(bf16_t*)(w + WS_PROJ), SSQ(w, 3 * l + 1)}; pg8::gemm_phase(lds, g, S, E); } SEAM(ph); ++ph;
            if (PHON(4) && IN(ph)) { for (int rep = 0; rep < NREP(4); ++rep) phase_prep(args, l, lds); } SEAM(ph); ++ph;
            if (PHON(5) && IN(ph)) { for (int rep = 0; rep < NREP(5); ++rep) phase_scan(args, l, lds); } SEAM(ph); ++ph;
            if (PHON(6) && IN(ph)) { for (int rep = 0; rep < NREP(6); ++rep) phase_post(args, l); } SEAM(ph); ++ph;
            if (PHON(7) && IN(ph)) { OPQ(w); pg8::Gemm g{(bf16_t*)(w + WS_Y), (const bf16_t*)(w + wlo + WL_BR), 3072, 3072, 1024, (float*)(w + WS_SLAB), TKP(w)}; pg8::Order<3> S; S.init(DM / 256, 1024, 2, G, (int)blockIdx.x);
                pg8::EpiBranch E{(const bf16_t*)(w + WS_PROJ), (float*)(w + WS_PART), (bf16_t*)(w + WS_MRG)}; pg8::gemm_phase(lds, g, S, E); } SEAM(ph); ++ph;
            if (PHON(8) && IN(ph)) { OPQ(w); pg8::Gemm g{(bf16_t*)(w + WS_MRG), (const bf16_t*)(w + wlo + WL_OUT), DM, DM, DM, (float*)(w + WS_SLAB), TKP(w)}; pg8::Order<1> S; S.init(DM / 256, DM, 4, G, (int)blockIdx.x);
                pg8::EpiResid E{(float*)(w + WS_X), (bf16_t*)(w + WS_XB), SSQ(w, 3 * l + 2), 1.0f}; pg8::gemm_phase(lds, g, S, E); } SEAM(ph); ++ph;
        }
    }
    if (PHON(9) && IN(ph)) { phase_final(args); } ++ph;
#undef IN
#undef SEAM
}
constexpr int N_PHASES = 1 + DEPTH * 10 + 1;

extern "C" void kernel_launch(void* const* d_in, const int* in_sizes, int n_in, void* d_out, int out_size, void* d_ws, size_t ws_size, hipStream_t stream) {
    static int grid = 0;
    if (grid == 0) {
        if (n_in != 30 || (size_t)out_size != O_END || ws_size < WS_END) { fprintf(stderr, "kernel_launch: unexpected problem: n_in %d out %d ws %zu (need %zu)\n", n_in, out_size, ws_size, (size_t)WS_END); grid = -1; return; }
        int dev = 0, cus = 0, per_cu = 0;
        if (hipGetDevice(&dev) != hipSuccess || hipDeviceGetAttribute(&cus, hipDeviceAttributeMultiprocessorCount, dev) != hipSuccess) { grid = -1; return; }
        if (hipFuncSetAttribute((const void*)fwd, hipFuncAttributeMaxDynamicSharedMemorySize, LDS_BYTES) != hipSuccess) { fprintf(stderr, "kernel_launch: hipFuncSetAttribute failed\n"); grid = -1; return; }
        if (hipOccupancyMaxActiveBlocksPerMultiprocessor(&per_cu, (const void*)fwd, 512, LDS_BYTES) != hipSuccess || per_cu < 1) fprintf(stderr, "kernel_launch: occupancy query reports %d\n", per_cu);
        (void)hipGetLastError();
        grid = cus;
    }
    if (grid < 0) return;
    (void)hipMemsetAsync((char*)d_ws + WS_CTL, 0, CTL_ZERO_BYTES, stream);
    Args a{};
    for (int i = 0; i < 30; ++i) a.in[i] = (const float*)d_in[i];
    a.out = (float*)d_out; a.ws = (unsigned char*)d_ws;
#if MK_PER_PHASE
    for (int p = 0; p < N_PHASES; ++p) { a.ph_lo = p; a.ph_hi = p + 1; hipLaunchKernelGGL(fwd, dim3(grid), dim3(512), LDS_BYTES, stream, a); }
#else
    a.ph_lo = 0; a.ph_hi = N_PHASES; hipLaunchKernelGGL(fwd, dim3(grid), dim3(512), LDS_BYTES, stream, a);
#endif
}
```
